# Optimizing an MI355X kernel written in HIP

```python
import math
import jax, jax.numpy as jnp
from jax import lax
import numpy as np

D_MODEL = 2048
BATCH = 4
SEQ = 4096
DEPTH = 2

F32 = jnp.float32

ALPHA = (2.0 * DEPTH) ** 0.25
BETA = (8.0 * DEPTH) ** -0.25

RWKV_HEAD_DIM = 64
RWKV_DIM = D_MODEL // 2
RWKV_HEADS = RWKV_DIM // RWKV_HEAD_DIM
DECAY_LORA = 96
ICL_LORA = 96
GATE_LORA = 256
W_DECAY_SCALE = 0.606531
RWKV_GN_EPS = 64e-5
RWKV_SHIFT_COLS = 3 * RWKV_DIM + DECAY_LORA + ICL_LORA + GATE_LORA

GLA_HEADS = 4
GLA_VDIM = D_MODEL // 2
GLA_KDIM = GLA_VDIM // 2
GLA_DK = GLA_KDIM // GLA_HEADS
GLA_DV = GLA_VDIM // GLA_HEADS
GLA_GATE_LORA = 16
GLA_GATE_NORMALIZER = 16.0
GLA_CHUNK = 64
AB_IN = RWKV_SHIFT_COLS + 2 * GLA_KDIM + GLA_VDIM + GLA_GATE_LORA + GLA_VDIM
AB_OUT = RWKV_DIM + GLA_VDIM

DIFF_HEAD_DIM = 64
DIFF_V_DIM = 2 * DIFF_HEAD_DIM
DIFF_HEADS = D_MODEL // DIFF_V_DIM
DIFF_Q_DIM = DIFF_HEADS * 2 * DIFF_HEAD_DIM
DIFF_VDIM_TOT = DIFF_HEADS * DIFF_V_DIM
Q_BLOCK = 128
ROPE_THETA = 10000.0

D_FF = -(-(8 * D_MODEL) // (3 * 256)) * 256

N_EVEN = (DEPTH + 1) // 2
N_ODD = DEPTH // 2

kernel_name = "bidir_hybrid_rwkv7_gla_diffattn_deepnorm_adaln"


def _split(z, sizes):
    idx = np.cumsum(sizes)[:-1].tolist()
    return jnp.split(z, idx, axis=-1)


def _layer_norm(x, g, b, eps=1e-5):
    xf = x.astype(F32)
    mu = jnp.mean(xf, -1, keepdims=True)
    var = jnp.mean(jnp.square(xf - mu), -1, keepdims=True)
    return ((xf - mu) * lax.rsqrt(var + eps)).astype(x.dtype) * g + b


def _rms_norm(x, g, eps=1e-5):
    xf = x.astype(F32)
    return (xf * lax.rsqrt(jnp.mean(xf * xf, -1, keepdims=True) + eps)).astype(x.dtype) * g


def _l2norm(t, eps=1e-12):
    tf = t.astype(F32)
    return (tf / jnp.maximum(jnp.sqrt(jnp.sum(tf * tf, -1, keepdims=True)), eps)).astype(t.dtype)


def _centred_shift(z):
    zp = jnp.pad(z, ((0, 0), (1, 1), (0, 0)))
    return 0.5 * (zp[:, :-2] + zp[:, 2:])


def _ada(c, w, b):
    mod = jax.nn.silu(c) @ w + b
    shift, scale, gate = jnp.split(mod[:, None, :], 3, axis=-1)
    return shift, scale, gate


def _rwkv7_scan(r, w, k, v, kk, a):
    dt = r.dtype
    xs = tuple(t.astype(F32) for t in (r, w, k, v, kk, a))

    def step(S, inp):
        r_t, w_t, k_t, v_t, kk_t, a_t = inp
        sa = -jnp.einsum('dbhvk,dbhk->dbhv', S, kk_t)
        S = (S * w_t[..., None, :] + sa[..., :, None] * (kk_t * a_t)[..., None, :]
             + v_t[..., :, None] * k_t[..., None, :])
        return S, jnp.einsum('dbhvk,dbhk->dbhv', S, r_t)

    S0 = jnp.zeros(r.shape[1:] + (r.shape[-1],), F32)
    _, y = lax.scan(step, S0, xs)
    return y.astype(dt)


def _rwkv7_mixer(z, mu, w0, w_up, a0, a_up, g_up, k_k, k_a, r_k, gn_g, gn_b):
    B, T, _ = z.shape
    H, N = RWKV_HEADS, RWKV_HEAD_DIM
    z = z + (_centred_shift(z) - z) * mu
    r, k, v, wd, ad, gd = _split(z, (RWKV_DIM, RWKV_DIM, RWKV_DIM, DECAY_LORA, ICL_LORA, GATE_LORA))
    w = jnp.exp(-W_DECAY_SCALE * jax.nn.sigmoid(
        w0[:, None, None, :] + jnp.einsum('btr,drc->dbtc', jnp.tanh(wd), w_up)))
    a = jax.nn.sigmoid(a0 + ad @ a_up)
    g = jax.nn.sigmoid(gd) @ g_up
    heads = lambda t: t.reshape(t.shape[:-1] + (H, N))
    kk = _l2norm(heads(k * k_k))
    k = k * (1.0 + (a - 1.0) * k_a)
    r_h, k_h, v_h, a_h, w_h = heads(r), heads(k), heads(v), heads(a), heads(w)
    tm = lambda t: jnp.moveaxis(t, 1, 0)

    def both(t):
        t = tm(t)
        return jnp.stack([t, t[::-1]], axis=1)

    w_t = jnp.stack([tm(w_h[0]), tm(w_h[1])[::-1]], axis=1)
    y = _rwkv7_scan(both(r_h), w_t, both(k_h), both(v_h), both(kk), both(a_h))
    y = jnp.moveaxis(y[:, 0] + y[::-1, 1], 0, 1)
    y = _layer_norm(y, gn_g.reshape(H, N), gn_b.reshape(H, N), eps=RWKV_GN_EPS)
    y = y + jnp.sum(r_h * k_h * r_k, -1, keepdims=True) * v_h
    return y.reshape(B, T, RWKV_DIM) * g


def _gla_chunked(q, k, v, log_g):
    dt = v.dtype
    q, k, v, log_g = (t.astype(F32) for t in (q, k, v, log_g))
    T = q.shape[-2]
    n = T // GLA_CHUNK
    chunk = lambda t: t.reshape(t.shape[:-2] + (n, GLA_CHUNK, t.shape[-1]))
    q, k, v, log_g = chunk(q), chunk(k), chunk(v), chunk(log_g)
    b = lax.cumsum(log_g, axis=log_g.ndim - 2)
    b_last = b[..., -1:, :]
    qb = q * jnp.exp(b)
    kb = k * jnp.exp(-b)
    mask = jnp.tril(jnp.ones((GLA_CHUNK, GLA_CHUNK), bool))
    att = jnp.where(mask, jnp.einsum('...nid,...njd->...nij', qb, kb), 0.0)
    o = jnp.einsum('...nij,...njv->...niv', att, v)
    kv = jnp.einsum('...ncd,...ncv->...ndv', k * jnp.exp(b_last - b), v)
    decay = jnp.exp(b_last[..., 0, :])

    def step(S, inp):
        dec, kv_n = inp
        return S * dec[..., :, None] + kv_n, S

    S0 = jnp.zeros(kv.shape[:-3] + kv.shape[-2:], F32)
    _, S_prev = lax.scan(step, S0, (jnp.moveaxis(decay, -2, 0), jnp.moveaxis(kv, -3, 0)))
    S_prev = jnp.moveaxis(S_prev, 0, -3)
    o = o + jnp.einsum('...ncd,...ndv->...ncv', qb, S_prev)
    return o.reshape(o.shape[:-3] + (T, o.shape[-1])).astype(dt)


def _gla_mixer(q, k, v, gg, og, gate_up, gate_b, norm_g):
    B, T, _ = q.shape
    H = GLA_HEADS
    log_g = jax.nn.log_sigmoid(jnp.einsum('btr,drc->dbtc', gg, gate_up)
                               + gate_b[:, None, None, :]) / GLA_GATE_NORMALIZER

    def heads(t, dh):
        return jnp.swapaxes(t.reshape(t.shape[:-1] + (H, dh)), -3, -2)

    qh = heads(q, GLA_DK) * (GLA_DK ** -0.5)
    kh, vh, gh = heads(k, GLA_DK), heads(v, GLA_DV), heads(log_g, GLA_DK)
    flip = lambda t: t[..., ::-1, :]
    both = lambda t: jnp.stack([t, flip(t)])
    o = _gla_chunked(both(qh), both(kh), both(vh), jnp.stack([gh[0], flip(gh[1])]))
    o = o[0] + flip(o[1])
    o = _rms_norm(o, norm_g)
    o = jnp.swapaxes(o, 1, 2).reshape(B, T, GLA_VDIM)
    return o * jax.nn.silu(og)


def _mixer_ab(h, w_in, w_out, mu, w0, w_up, a0, a_up, g_up, k_k, k_a, r_k, gn_g, gn_b,
              gate_up, gate_b, norm_g):
    z = h @ w_in
    z_a, q, k, v, gg, og = _split(z, (RWKV_SHIFT_COLS, GLA_KDIM, GLA_KDIM, GLA_VDIM, GLA_GATE_LORA, GLA_VDIM))
    y_a = _rwkv7_mixer(z_a, mu, w0, w_up, a0, a_up, g_up, k_k, k_a, r_k, gn_g, gn_b)
    y_b = _gla_mixer(q, k, v, gg, og, gate_up, gate_b, norm_g)
    return jnp.concatenate([y_a, y_b], -1) @ w_out


def _rope_tables(T, d, dtype):
    inv = ROPE_THETA ** (-jnp.arange(0, d, 2, dtype=F32) / d)
    ang = jnp.arange(T, dtype=F32)[:, None] * inv[None, :]
    return jnp.cos(ang).astype(dtype), jnp.sin(ang).astype(dtype)


def _apply_rope(x, cos, sin):
    cos, sin = cos[:, None, None, :], sin[:, None, None, :]
    x1, x2 = jnp.split(x, 2, axis=-1)
    return jnp.concatenate([x1 * cos - x2 * sin, x2 * cos + x1 * sin], -1)


def _lambda_init(layer):
    return 0.8 - 0.6 * math.exp(-0.3 * layer)


def _mixer_c(h, w_in, w_out, lam_params, subln_g, lambda_init):
    B, T, _ = h.shape
    H, d = DIFF_HEADS, DIFF_HEAD_DIM
    q, k, v = _split(h @ w_in, (DIFF_Q_DIM, DIFF_Q_DIM, DIFF_VDIM_TOT))
    q = q.reshape(B, T, H, 2, d)
    k = k.reshape(B, T, H, 2, d)
    v = v.reshape(B, T, H, DIFF_V_DIM)
    cos, sin = _rope_tables(T, d, q.dtype)
    q, k = _apply_rope(q, cos, sin), _apply_rope(k, cos, sin)
    lp = lam_params.astype(F32)
    lam = jnp.exp(jnp.sum(lp[0] * lp[1])) - jnp.exp(jnp.sum(lp[2] * lp[3])) + lambda_init
    scale = d ** -0.5
    q_blocks = jnp.moveaxis(q.reshape(B, T // Q_BLOCK, Q_BLOCK, H, 2, d), 1, 0)

    def block(q_blk):
        s = jnp.einsum('bqhcd,bkhcd->bhcqk', q_blk, k, preferred_element_type=F32) * scale
        p = jax.nn.softmax(s, axis=-1)
        p = p[:, :, 0] - lam * p[:, :, 1]
        return jnp.einsum('bhqk,bkhv->bqhv', p.astype(v.dtype), v)

    o = lax.map(block, q_blocks)
    o = jnp.moveaxis(o, 0, 1).reshape(B, T, H, DIFF_V_DIM)
    o = _rms_norm(o, subln_g) * (1.0 - lambda_init)
    return o.reshape(B, T, DIFF_VDIM_TOT) @ w_out


def _swiglu(h, w_in, w_out):
    gate, up = jnp.split(h @ w_in, 2, axis=-1)
    return (jax.nn.silu(gate) * up) @ w_out


def setup_inputs(seed: int = 0) -> dict:
    key = jax.random.key(seed)
    ks = iter(jax.random.split(key, 40))
    nrm = lambda shape, s: jax.random.normal(next(ks), shape, F32) * s
    D = D_MODEL
    return {
        "x": nrm((BATCH, SEQ, D), 1.0),
        "c": nrm((BATCH, D), 1.0),
        "ada_w": nrm((DEPTH, 2, D, 3 * D), 0.2 * D ** -0.5),
        "ada_b": nrm((DEPTH, 2, 3 * D), 0.01),
        "ln_g": 1.0 + nrm((DEPTH, 2, D), 0.02),
        "ln_b": nrm((DEPTH, 2, D), 0.02),
        "ffn_w_in": nrm((DEPTH, D, 2 * D_FF), D ** -0.5),
        "ffn_w_out": nrm((DEPTH, D_FF, D), BETA * D_FF ** -0.5),
        "ab_w_in": nrm((N_EVEN, D, AB_IN), D ** -0.5),
        "ab_w_out": nrm((N_EVEN, AB_OUT, D), BETA * AB_OUT ** -0.5),
        "rwkv_mu": jax.random.uniform(next(ks), (N_EVEN, RWKV_SHIFT_COLS), F32),
        "rwkv_w0": jax.random.uniform(next(ks), (N_EVEN, 2, RWKV_DIM), F32, -4.0, 1.0),
        "rwkv_w_up": nrm((N_EVEN, 2, DECAY_LORA, RWKV_DIM), 0.1),
        "rwkv_a0": nrm((N_EVEN, RWKV_DIM), 0.5),
        "rwkv_a_up": nrm((N_EVEN, ICL_LORA, RWKV_DIM), ICL_LORA ** -0.5),
        "rwkv_g_up": nrm((N_EVEN, GATE_LORA, RWKV_DIM), GATE_LORA ** -0.5),
        "rwkv_k_k": 0.85 + nrm((N_EVEN, RWKV_DIM), 0.1),
        "rwkv_k_a": 1.0 + nrm((N_EVEN, RWKV_DIM), 0.1),
        "rwkv_r_k": nrm((N_EVEN, RWKV_HEADS, RWKV_HEAD_DIM), 0.1),
        "rwkv_gn_g": 1.0 + nrm((N_EVEN, RWKV_DIM), 0.02),
        "rwkv_gn_b": nrm((N_EVEN, RWKV_DIM), 0.02),
        "gla_gate_up": nrm((N_EVEN, 2, GLA_GATE_LORA, GLA_KDIM), GLA_GATE_LORA ** -0.5),
        "gla_gate_b": nrm((N_EVEN, 2, GLA_KDIM), 1.0),
        "gla_norm_g": 1.0 + nrm((N_EVEN, GLA_DV), 0.02),
        "diff_w_in": nrm((N_ODD, D, 2 * DIFF_Q_DIM + DIFF_VDIM_TOT), D ** -0.5),
        "diff_w_out": nrm((N_ODD, DIFF_VDIM_TOT, D), BETA * DIFF_VDIM_TOT ** -0.5),
        "diff_lambda": nrm((N_ODD, 4, DIFF_HEAD_DIM), 0.1),
        "diff_subln_g": 1.0 + nrm((N_ODD, DIFF_V_DIM), 0.02),
    }


def reference(x, c, ada_w, ada_b, ln_g, ln_b, ffn_w_in, ffn_w_out, ab_w_in, ab_w_out,
              rwkv_mu, rwkv_w0, rwkv_w_up, rwkv_a0, rwkv_a_up, rwkv_g_up, rwkv_k_k, rwkv_k_a,
              rwkv_r_k, rwkv_gn_g, rwkv_gn_b, gla_gate_up, gla_gate_b, gla_norm_g,
              diff_w_in, diff_w_out, diff_lambda, diff_subln_g):
    for i in range(DEPTH):
        j = i // 2
        shift, scale, gate = _ada(c, ada_w[i, 0], ada_b[i, 0])
        h = x * (1.0 + scale) + shift
        if i % 2 == 0:
            y = _mixer_ab(h, ab_w_in[j], ab_w_out[j], rwkv_mu[j], rwkv_w0[j], rwkv_w_up[j],
                          rwkv_a0[j], rwkv_a_up[j], rwkv_g_up[j], rwkv_k_k[j], rwkv_k_a[j],
                          rwkv_r_k[j], rwkv_gn_g[j], rwkv_gn_b[j],
                          gla_gate_up[j], gla_gate_b[j], gla_norm_g[j])
        else:
            y = _mixer_c(h, diff_w_in[j], diff_w_out[j], diff_lambda[j], diff_subln_g[j],
                         _lambda_init(i))
        x = _layer_norm(ALPHA * x + (1.0 + gate) * y, ln_g[i, 0], ln_b[i, 0])
        shift, scale, gate = _ada(c, ada_w[i, 1], ada_b[i, 1])
        h = x * (1.0 + scale) + shift
        y = _swiglu(h, ffn_w_in[i], ffn_w_out[i])
        x = _layer_norm(ALPHA * x + (1.0 + gate) * y, ln_g[i, 1], ln_b[i, 1])
    return x
```

```cpp
#include <hip/hip_runtime.h>
#include <hip/hip_cooperative_groups.h>
#include <cstdio>
namespace cg = cooperative_groups;

#ifndef MK_SINGLE
#define MK_SINGLE 1
#endif

#define LAS __attribute__((address_space(3)))
typedef unsigned short u16;
typedef _Float16 f16;
typedef short bf16x8 __attribute__((ext_vector_type(8)));
typedef float f32x4 __attribute__((ext_vector_type(4)));
typedef float f32x16 __attribute__((ext_vector_type(16)));
typedef float f32x2 __attribute__((ext_vector_type(2)));
typedef _Float16 f16x8 __attribute__((ext_vector_type(8)));
typedef _Float16 f16x4 __attribute__((ext_vector_type(4)));
typedef _Float16 f16x2 __attribute__((ext_vector_type(2)));
typedef unsigned u32x4 __attribute__((ext_vector_type(4)));
typedef unsigned u32x2 __attribute__((ext_vector_type(2)));

constexpr int ZLD = 6656;
constexpr float ALPHA_C = 1.41421356237f;
constexpr float LINIT = 0.35550906759f;
constexpr int NPHASE = 20;

constexpr size_t OFF_WB_ABIN = 0;
constexpr size_t OFF_WB_LORA = OFF_WB_ABIN + (size_t)6656 * 2048 * 2;
constexpr size_t OFF_WB_ABOUT = OFF_WB_LORA + (size_t)4096 * 512 * 2;
constexpr size_t OFF_WB_FFNIN0 = OFF_WB_ABOUT + (size_t)2048 * 2048 * 2;
constexpr size_t OFF_WB_FFNIN1 = OFF_WB_FFNIN0 + (size_t)11264 * 2048 * 2;
constexpr size_t OFF_WB_FFNOUT0 = OFF_WB_FFNIN1 + (size_t)11264 * 2048 * 2;
constexpr size_t OFF_WB_FFNOUT1 = OFF_WB_FFNOUT0 + (size_t)2048 * 5632 * 2;
constexpr size_t OFF_WB_DIN = OFF_WB_FFNOUT1 + (size_t)2048 * 5632 * 2;
constexpr size_t OFF_WB_DOUT = OFF_WB_DIN + (size_t)6144 * 2048 * 2;
constexpr size_t OFF_PART = OFF_WB_DOUT + (size_t)2048 * 2048 * 2;
constexpr size_t OFF_MODS = OFF_PART + (size_t)16 * 98304 * 4;
constexpr size_t OFF_ROPE = OFF_MODS + (size_t)98304 * 4;
constexpr size_t OFF_H = OFF_ROPE + (size_t)2 * 4096 * 32 * 4;
constexpr size_t OFF_Z = OFF_H + (size_t)16384 * 2048 * 2;
constexpr size_t OFF_L = OFF_Z + (size_t)16384 * 6656 * 2;
constexpr size_t OFF_WAG = OFF_L + (size_t)16384 * 512 * 2;
constexpr size_t OFF_YS = OFF_WAG + (size_t)16384 * 4096 * 2;
constexpr size_t OFF_OS = OFF_YS + (size_t)2 * 16384 * 1024 * 2;
constexpr size_t OFF_BAR = OFF_OS + (size_t)2 * 16384 * 1024 * 2;
constexpr size_t WS_TOTAL = OFF_BAR + 16384;
constexpr size_t OFF_VT = OFF_Z + (size_t)16384 * 4096 * 2;

struct Params {
    const float *x, *c, *ada_w, *ada_b, *ln_g, *ln_b, *ffn_w_in, *ffn_w_out, *ab_w_in, *ab_w_out;
    const float *rwkv_mu, *rwkv_w0, *rwkv_w_up, *rwkv_a0, *rwkv_a_up, *rwkv_g_up, *rwkv_k_k, *rwkv_k_a, *rwkv_r_k, *rwkv_gn_g, *rwkv_gn_b;
    const float *gla_gate_up, *gla_gate_b, *gla_norm_g, *diff_w_in, *diff_w_out, *diff_lambda, *diff_subln_g;
    float* out;
    unsigned char* ws;
};

__device__ __forceinline__ int ltid() { int t = (int)threadIdx.x; asm volatile("" : "+v"(t)); return t; }
__device__ __forceinline__ u16 f2bf(float f) { unsigned u = __float_as_uint(f); u += 0x7FFFu + ((u >> 16) & 1u); return (u16)(u >> 16); }
__device__ __forceinline__ unsigned cvt_pk_bf16(float lo, float hi) { unsigned r; asm volatile("v_cvt_pk_bf16_f32 %0, %1, %2" : "=v"(r) : "v"(lo), "v"(hi)); return r; }
__device__ __forceinline__ float sigmoidf_(float x) { return 1.0f / (1.0f + __expf(-x)); }
__device__ __forceinline__ float dpp_sum16(float x) {
    x += __builtin_bit_cast(float, __builtin_amdgcn_update_dpp(0, __builtin_bit_cast(int, x), 0xB1, 0xF, 0xF, true));
    x += __builtin_bit_cast(float, __builtin_amdgcn_update_dpp(0, __builtin_bit_cast(int, x), 0x4E, 0xF, 0xF, true));
    x += __builtin_bit_cast(float, __builtin_amdgcn_update_dpp(0, __builtin_bit_cast(int, x), 0x141, 0xF, 0xF, true));
    x += __builtin_bit_cast(float, __builtin_amdgcn_update_dpp(0, __builtin_bit_cast(int, x), 0x140, 0xF, 0xF, true));
    return x;
}
__device__ __forceinline__ float wave_sum(float x) {
    x = dpp_sum16(x);
    const float s0 = __uint_as_float(__builtin_amdgcn_readlane(__float_as_uint(x), 0)), s1 = __uint_as_float(__builtin_amdgcn_readlane(__float_as_uint(x), 16));
    const float s2 = __uint_as_float(__builtin_amdgcn_readlane(__float_as_uint(x), 32)), s3 = __uint_as_float(__builtin_amdgcn_readlane(__float_as_uint(x), 48));
    return (s0 + s1) + (s2 + s3);
}

namespace pg8 {
constexpr int BM = 256, BK = 64, HALF = 128, HTB = HALF * BK * 2, STAGE_BYTES = 8 * HTB, NXCD = 8, WGM = 8;
__host__ __device__ __forceinline__ int lds_byte(int r, int c) { const int st = (r >> 4) * 2 + (c >> 5), rr = r & 15, cc = c & 31, ob = rr * 64 + cc * 2; return st * 1024 + (ob ^ (((ob >> 9) & 1) << 5)); }
__host__ __device__ __forceinline__ void stage_rc(int b, int& R, int& C) { const int st = b / 1024, sb = b % 1024, swz = sb ^ (((sb >> 9) & 1) << 5); R = (st >> 1) * 16 + swz / 64; C = (st & 1) * 32 + (swz % 64) / 2; }
__host__ __device__ __forceinline__ int perm32(int rho) { const int n = rho >> 4, i = rho & 15; return 8 * (i >> 2) + 4 * n + (i & 3); }
struct Unit { int pm, pn; };
struct Gemm { const u16* A; const u16* Bt; int M, N, K; };
struct StaticOrder {
    int nM, nN, nwg, G, c;
    __device__ void init(int M, int N, int G_, int c_) { nM = M / BM; nN = N / BM; nwg = nM * nN; G = G_; c = c_; }
    __device__ bool next(int i, Unit& u) const {
        const long L = (long)i * G + c; if (L >= nwg) return false;
        int wgid = (int)L; { const int q = nwg / NXCD, r = nwg % NXCD, xcd = wgid % NXCD, off = wgid / NXCD; wgid = (xcd < r ? xcd * (q + 1) : r * (q + 1) + (xcd - r) * q) + off; }
        const int nig = WGM * nN, gid = wgid / nig, fm = gid * WGM, gsz = (nM - fm) < WGM ? (nM - fm) : WGM;
        u.pm = fm + ((wgid % nig) % gsz); u.pn = (wgid % nig) / gsz; return true;
    }
};

template <class Epi>
__device__ __forceinline__ void gemm_phase(LAS unsigned char* lds, const Gemm g, const StaticOrder& S, const Epi& E) {
    const int tid = ltid(), wid = __builtin_amdgcn_readfirstlane(tid >> 6), lane = tid & 63, wr = wid >> 2, wc = wid & 3, fr = lane & 15, fq = lane >> 4;
    const int K = g.K, nt = K / BK;
    unsigned voffA[2], voffB[2];
#pragma unroll
    for (int i = 0; i < 2; ++i) { int R, C; stage_rc(tid * 16 + i * 8192, R, C); const int Rb = Epi::PERM ? ((R & ~31) + perm32(R & 31)) : R;
        voffA[i] = (unsigned)(R * K + C) * 2u; voffB[i] = (unsigned)(Rb * K + C) * 2u; }
    const size_t kstep = (size_t)(BK * 2);
    const size_t hstep = (size_t)HALF * K * 2;
    const size_t tstep = 2 * hstep;
    const unsigned ldsw = (unsigned)wid * 1024u;
    const int aoff = lds_byte(wr * 64 + fr, fq * 8), boff = lds_byte(wc * 32 + fr, fq * 8);
#define PG8_SA(b, h) (((b) * 2 + (h)) * HTB)
#define PG8_SB(b, h) ((4 + (b) * 2 + (h)) * HTB)
#define PG8_STAGE(bufoff, gbase, voff) do { _Pragma("unroll") for (int _i = 0; _i < 2; ++_i) \
        __builtin_amdgcn_global_load_lds((const unsigned*)((const char*)(gbase) + (voff)[_i]), (LAS unsigned*)(lds + (bufoff) + ldsw + _i * 8192), 16, 0, 0); } while (0)
#define PG8_LDA(dst, b, h) do { _Pragma("unroll") for (int m = 0; m < 4; ++m) _Pragma("unroll") for (int k = 0; k < 2; ++k) dst[m][k] = *(const LAS bf16x8*)(lds + PG8_SA(b, h) + aoff + m * 2048 + k * 1024); } while (0)
#define PG8_LDB(dst, b, h) do { _Pragma("unroll") for (int n = 0; n < 2; ++n) _Pragma("unroll") for (int k = 0; k < 2; ++k) dst[n][k] = *(const LAS bf16x8*)(lds + PG8_SB(b, h) + boff + n * 2048 + k * 1024); } while (0)
#define PG8_MMA(ai, bj, At, Bt) do { __builtin_amdgcn_s_setprio(1); _Pragma("unroll") for (int m = 0; m < 4; ++m) _Pragma("unroll") for (int n = 0; n < 2; ++n) _Pragma("unroll") for (int k = 0; k < 2; ++k) \
        acc[ai][bj][m][n] = __builtin_amdgcn_mfma_f32_16x16x32_bf16(Bt[n][k], At[m][k], acc[ai][bj][m][n], 0, 0, 0); __builtin_amdgcn_s_setprio(0); } while (0)
#define PG8_WAIT_V(n) asm volatile("s_waitcnt vmcnt(" #n ")" ::: "memory")
#define PG8_WAIT_L(n) asm volatile("s_waitcnt lgkmcnt(" #n ")" ::: "memory")
#define PG8_BAR __builtin_amdgcn_s_barrier()
#define PG8_SCHED __builtin_amdgcn_sched_barrier(0)
    Unit cur, nxt; int ui = 0;
    if (!S.next(0, cur)) return;
    f32x4 acc[2][2][4][2];
#pragma unroll
    for (int a = 0; a < 2; ++a)
#pragma unroll
        for (int b = 0; b < 2; ++b)
#pragma unroll
            for (int m = 0; m < 4; ++m)
#pragma unroll
                for (int n = 0; n < 2; ++n) acc[a][b][m][n] = (f32x4){0.f, 0.f, 0.f, 0.f};
    bf16x8 At[4][2], B0[2][2], B1[2][2];
    const char* cA = (const char*)g.A + (size_t)cur.pm * tstep; const char* cB = (const char*)g.Bt + (size_t)cur.pn * tstep;
    PG8_STAGE(PG8_SB(0, 0), cB, voffB); PG8_STAGE(PG8_SA(0, 0), cA, voffA); PG8_STAGE(PG8_SB(0, 1), cB + hstep, voffB); PG8_STAGE(PG8_SA(0, 1), cA + hstep, voffA);
    if (wr == 1) PG8_BAR;
    PG8_WAIT_V(4); PG8_BAR;
    PG8_STAGE(PG8_SB(1, 0), cB + kstep, voffB); PG8_STAGE(PG8_SA(1, 0), cA + kstep, voffA); PG8_STAGE(PG8_SB(1, 1), cB + hstep + kstep, voffB);
    PG8_WAIT_V(6); PG8_BAR;
    for (;;) {
        const bool has_next = S.next(ui + 1, nxt);
        const char* nA = has_next ? (const char*)g.A + (size_t)nxt.pm * tstep : cA; const char* nB = has_next ? (const char*)g.Bt + (size_t)nxt.pn * tstep : cB;
        for (int t = 0; t < nt; t += 2) {
            const bool last = (t == nt - 2);
            const char* a1 = cA + (size_t)(t + 1) * kstep;
            const char* a2 = last ? nA : cA + (size_t)(t + 2) * kstep; const char* b2 = last ? nB : cB + (size_t)(t + 2) * kstep;
            const char* a3 = a2 + kstep; const char* b3 = b2 + kstep;
            PG8_LDB(B0, 0, 0); PG8_SCHED; PG8_LDA(At, 0, 0); PG8_STAGE(PG8_SA(1, 1), a1 + hstep, voffA);
            PG8_WAIT_L(8); PG8_BAR; PG8_WAIT_L(0); PG8_MMA(0, 0, At, B0); PG8_BAR; PG8_SCHED;
            PG8_LDB(B1, 0, 1); PG8_STAGE(PG8_SB(0, 0), b2, voffB);
            PG8_BAR; PG8_WAIT_L(0); PG8_MMA(0, 1, At, B1); PG8_BAR;
            PG8_LDA(At, 0, 1); PG8_STAGE(PG8_SA(0, 0), a2, voffA);
            PG8_BAR; PG8_WAIT_L(0); PG8_MMA(1, 0, At, B0); PG8_BAR; PG8_SCHED;
            PG8_STAGE(PG8_SB(0, 1), b2 + hstep, voffB);
            PG8_WAIT_V(6); PG8_BAR; PG8_MMA(1, 1, At, B1); PG8_BAR;
            PG8_LDB(B0, 1, 0); PG8_SCHED; PG8_LDA(At, 1, 0); PG8_STAGE(PG8_SA(0, 1), a2 + hstep, voffA);
            PG8_WAIT_L(8); PG8_BAR; PG8_WAIT_L(0); PG8_MMA(0, 0, At, B0); PG8_BAR; PG8_SCHED;
            PG8_LDB(B1, 1, 1); PG8_STAGE(PG8_SB(1, 0), b3, voffB);
            PG8_BAR; PG8_WAIT_L(0); PG8_MMA(0, 1, At, B1); PG8_BAR;
            PG8_LDA(At, 1, 1); PG8_STAGE(PG8_SA(1, 0), a3, voffA);
            PG8_BAR; PG8_WAIT_L(0); PG8_MMA(1, 0, At, B0); PG8_BAR; PG8_SCHED;
            PG8_STAGE(PG8_SB(1, 1), b3 + hstep, voffB);
            PG8_WAIT_V(6); PG8_BAR; PG8_MMA(1, 1, At, B1); PG8_BAR;
        }
        E(acc, cur, wr, wc, fr, fq);
        if (!has_next) break;
#pragma unroll
        for (int a = 0; a < 2; ++a)
#pragma unroll
            for (int b = 0; b < 2; ++b)
#pragma unroll
                for (int m = 0; m < 4; ++m)
#pragma unroll
                    for (int n = 0; n < 2; ++n) acc[a][b][m][n] = (f32x4){0.f, 0.f, 0.f, 0.f};
        cur = nxt; cA = nA; cB = nB; ++ui;
    }
    PG8_WAIT_V(0);
    if (wr == 0) PG8_BAR;
    PG8_BAR;
#undef PG8_SA
#undef PG8_SB
#undef PG8_STAGE
#undef PG8_LDA
#undef PG8_LDB
#undef PG8_MMA
#undef PG8_WAIT_V
#undef PG8_WAIT_L
#undef PG8_BAR
#undef PG8_SCHED
}
}
using pg8::Unit;

struct EpiF32 {
    static constexpr bool PERM = false;
    float* C; int ldc;
    __device__ __forceinline__ void operator()(const f32x4 (&acc)[2][2][4][2], const Unit& u, int wr, int wc, int fr, int fq) const {
        const int row0 = u.pm * 256 + wr * 64 + fr, col0 = u.pn * 256 + wc * 32 + 4 * fq;
#pragma unroll
        for (int ai = 0; ai < 2; ++ai)
#pragma unroll
            for (int m = 0; m < 4; ++m) { float* rowp = C + (size_t)(row0 + ai * 128 + m * 16) * ldc + col0;
#pragma unroll
                for (int bj = 0; bj < 2; ++bj)
#pragma unroll
                    for (int n = 0; n < 2; ++n) *(f32x4*)(rowp + bj * 128 + n * 16) = acc[ai][bj][m][n]; }
    }
};
struct EpiF16 {
    static constexpr bool PERM = true;
    f16* O; int ldc;
    __device__ __forceinline__ void operator()(const f32x4 (&acc)[2][2][4][2], const Unit& u, int wr, int wc, int fr, int fq) const {
        const int row0 = u.pm * 256 + wr * 64 + fr, col0 = u.pn * 256 + wc * 32 + 8 * fq;
#pragma unroll
        for (int ai = 0; ai < 2; ++ai)
#pragma unroll
            for (int m = 0; m < 4; ++m) { f16* rowp = O + (size_t)(row0 + ai * 128 + m * 16) * ldc + col0;
#pragma unroll
                for (int bj = 0; bj < 2; ++bj) { f16x8 v;
#pragma unroll
                    for (int i = 0; i < 4; ++i) { v[i] = (f16)acc[ai][bj][m][0][i]; v[4 + i] = (f16)acc[ai][bj][m][1][i]; }
                    *(f16x8*)(rowp + bj * 128) = v; } }
    }
};
struct EpiWAG {
    static constexpr bool PERM = true;
    f16* O; const float* w0; const float* a0;
    __device__ __forceinline__ void operator()(const f32x4 (&acc)[2][2][4][2], const Unit& u, int wr, int wc, int fr, int fq) const {
        const int type = u.pn >> 2;
        const int row0 = u.pm * 256 + wr * 64 + fr, col0 = u.pn * 256 + wc * 32 + 8 * fq, cl0 = (u.pn & 3) * 256 + wc * 32 + 8 * fq;
        f32x4 bv[2][2];
#pragma unroll
        for (int bj = 0; bj < 2; ++bj)
#pragma unroll
            for (int n = 0; n < 2; ++n) {
                if (type < 2) bv[bj][n] = *(const f32x4*)(w0 + type * 1024 + cl0 + bj * 128 + 4 * n);
                else if (type == 2) bv[bj][n] = *(const f32x4*)(a0 + cl0 + bj * 128 + 4 * n);
                else bv[bj][n] = (f32x4){0.f, 0.f, 0.f, 0.f};
            }
#pragma unroll
        for (int ai = 0; ai < 2; ++ai)
#pragma unroll
            for (int m = 0; m < 4; ++m) { f16* rowp = O + (size_t)(row0 + ai * 128 + m * 16) * 4096 + col0;
#pragma unroll
                for (int bj = 0; bj < 2; ++bj) { f16x8 v;
#pragma unroll
                    for (int n = 0; n < 2; ++n)
#pragma unroll
                        for (int i = 0; i < 4; ++i) { float xv = acc[ai][bj][m][n][i] + bv[bj][n][i]; float r;
                            if (type < 2) { const float sg = sigmoidf_(xv); r = -expm1f(-0.606531f * sg); }
                            else if (type == 2) r = sigmoidf_(xv);
                            else r = xv;
                            v[4 * n + i] = (f16)r; }
                    *(f16x8*)(rowp + bj * 128) = v; } }
    }
};
struct EpiSwiGLU {
    static constexpr bool PERM = true;
    u16* O;
    __device__ __forceinline__ void operator()(const f32x4 (&acc)[2][2][4][2], const Unit& u, int wr, int wc, int fr, int fq) const {
        const int row0 = u.pm * 256 + wr * 64 + fr, col0 = u.pn * 128 + wc * 32 + 8 * fq;
#pragma unroll
        for (int ai = 0; ai < 2; ++ai)
#pragma unroll
            for (int m = 0; m < 4; ++m) { float hv[8];
#pragma unroll
                for (int n = 0; n < 2; ++n)
#pragma unroll
                    for (int i = 0; i < 4; ++i) { const float gt = acc[ai][0][m][n][i], up = acc[ai][1][m][n][i]; hv[4 * n + i] = gt * sigmoidf_(gt) * up; }
                u32x4 o; o[0] = cvt_pk_bf16(hv[0], hv[1]); o[1] = cvt_pk_bf16(hv[2], hv[3]); o[2] = cvt_pk_bf16(hv[4], hv[5]); o[3] = cvt_pk_bf16(hv[6], hv[7]);
                *(u32x4*)(O + (size_t)(row0 + ai * 128 + m * 16) * 5632 + col0) = o; }
    }
};
struct EpiQKV {
    static constexpr bool PERM = false;
    u16* QK; u16* VT; const float* cs; const float* sn;
    __device__ __forceinline__ void operator()(const f32x4 (&acc)[2][2][4][2], const Unit& u, int wr, int wc, int fr, int fq) const {
        const int row0 = u.pm * 256 + wr * 64 + fr;
        if (u.pn < 16) {
            const float qs = u.pn < 8 ? (0.125f * 1.44269504089f) : 1.0f;
            const int j0 = 16 * (wc & 1) + 4 * fq;
#pragma unroll
            for (int ai = 0; ai < 2; ++ai)
#pragma unroll
                for (int m = 0; m < 4; ++m) { const int row = row0 + ai * 128 + m * 16, t = row & 4095;
                    const f32x4 c4 = *(const f32x4*)(cs + t * 32 + j0), s4 = *(const f32x4*)(sn + t * 32 + j0);
#pragma unroll
                    for (int bj = 0; bj < 2; ++bj) { const int hh = 2 * bj + (wc >> 1);
                        const f32x4 x1 = acc[ai][bj][m][0], x2 = acc[ai][bj][m][1]; float o1[4], o2[4];
#pragma unroll
                        for (int i = 0; i < 4; ++i) { o1[i] = (x1[i] * c4[i] - x2[i] * s4[i]) * qs; o2[i] = (x2[i] * c4[i] + x1[i] * s4[i]) * qs; }
                        u16* dst = QK + (size_t)row * 4096 + u.pn * 256 + 64 * hh + j0;
                        u32x2 a, b; a[0] = cvt_pk_bf16(o1[0], o1[1]); a[1] = cvt_pk_bf16(o1[2], o1[3]); b[0] = cvt_pk_bf16(o2[0], o2[1]); b[1] = cvt_pk_bf16(o2[2], o2[3]);
                        *(u32x2*)dst = a; *(u32x2*)(dst + 32) = b; } }
        } else {
            const int cv0 = (u.pn - 16) * 256 + wc * 32 + 4 * fq;
#pragma unroll
            for (int ai = 0; ai < 2; ++ai)
#pragma unroll
                for (int m = 0; m < 4; ++m) { const int row = row0 + ai * 128 + m * 16, t = row & 4095, b = row >> 12;
#pragma unroll
                    for (int bj = 0; bj < 2; ++bj)
#pragma unroll
                        for (int n = 0; n < 2; ++n)
#pragma unroll
                            for (int i = 0; i < 4; ++i) { const int cv = cv0 + bj * 128 + n * 16 + i;
                                VT[((size_t)(b * 2048 + cv)) * 4096 + t] = f2bf(acc[ai][bj][m][n][i]); } }
        }
    }
};

template <class Epi>
__device__ __forceinline__ void run_gemm(unsigned char* lds, const u16* A, const u16* Bt, int N, int K, const Epi& E) {
    pg8::StaticOrder S; S.init(16384, N, (int)gridDim.x, (int)blockIdx.x);
    pg8::Gemm g; g.A = A; g.Bt = Bt; g.M = 16384; g.N = N; g.K = K;
    pg8::gemm_phase<Epi>((LAS unsigned char*)lds, g, S, E);
}

__device__ __forceinline__ int sigma_map(int mode, int n, int nsrc) {
    if (mode == 0) return n < nsrc ? n : -1;
    if (mode == 1) { const int pn = n >> 8, r = n & 255; return r < 128 ? pn * 128 + r : 5632 + pn * 128 + (r - 128); }
    if (n >= 4096) return n;
    const int pn = n >> 8, r = n & 255, w = r >> 5, nn = (r >> 4) & 1, l = r & 15;
    return pn * 256 + 64 * (w >> 1) + 32 * nn + 16 * (w & 1) + l;
}
__device__ __forceinline__ void convert_weight(const float* __restrict__ W, u16* __restrict__ Bt, int K, int nsrc, int np, int mode, float* tl) {
    const int tid = ltid(); const int nkt = K >> 7, ntile = nkt * (np >> 6);
    for (int tile = blockIdx.x; tile < ntile; tile += gridDim.x) {
        const int ktile = tile % nkt, ntl = tile / nkt; const int k0 = ktile << 7, n0 = ntl << 6;
        const int nn = tid & 63, kk0 = tid >> 6;
        const int src = sigma_map(mode, n0 + nn, nsrc);
        float v[16];
#pragma unroll
        for (int i = 0; i < 16; ++i) v[i] = src >= 0 ? __builtin_nontemporal_load(W + (size_t)(k0 + kk0 + 8 * i) * nsrc + src) : 0.f;
#pragma unroll
        for (int i = 0; i < 16; ++i) tl[(kk0 + 8 * i) * 65 + nn] = v[i];
        __syncthreads();
        const int n = tid >> 3, ks = tid & 7;
        u32x4 o0, o1;
#pragma unroll
        for (int j = 0; j < 4; ++j) { o0[j] = cvt_pk_bf16(tl[(16 * ks + 2 * j) * 65 + n], tl[(16 * ks + 2 * j + 1) * 65 + n]); o1[j] = cvt_pk_bf16(tl[(16 * ks + 8 + 2 * j) * 65 + n], tl[(16 * ks + 9 + 2 * j) * 65 + n]); }
        u16* dst = Bt + (size_t)(n0 + n) * K + k0 + 16 * ks;
        *(u32x4*)dst = o0; *(u32x4*)(dst + 8) = o1;
        __syncthreads();
    }
}
__device__ __forceinline__ void phase0(const Params& p, unsigned char* lds) {
    float* tl = (float*)lds;
    unsigned char* ws = p.ws;
    const int tid = ltid(); const int gtid = blockIdx.x * 512 + tid, nth = gridDim.x * 512;
    {
        float* sc = (float*)lds;
        float* part = (float*)(ws + OFF_PART);
        for (int it = blockIdx.x; it < 768; it += gridDim.x) {
            const int kc = it & 15, nc = (it >> 4) % 12, s = it / 192; const int k0 = kc * 128;
            { const int b = tid >> 7, kk = tid & 127; const float cv = p.c[b * 2048 + k0 + kk]; sc[tid] = cv * sigmoidf_(cv); }
            __syncthreads();
            const int n = nc * 512 + tid; const float* W = p.ada_w + ((size_t)s * 2048 + k0) * 6144 + n;
            float a0 = 0.f, a1 = 0.f, a2 = 0.f, a3 = 0.f;
#pragma unroll 16
            for (int kk = 0; kk < 128; ++kk) { const float w = __builtin_nontemporal_load(W + (size_t)kk * 6144); a0 += sc[kk] * w; a1 += sc[128 + kk] * w; a2 += sc[256 + kk] * w; a3 += sc[384 + kk] * w; }
            float* po = part + (size_t)kc * 98304 + s * 24576 + n;
            po[0] = a0; po[6144] = a1; po[12288] = a2; po[18432] = a3;
            __syncthreads();
        }
    }
    convert_weight(p.ab_w_in, (u16*)(ws + OFF_WB_ABIN), 2048, 6608, 6656, 0, tl);
    convert_weight(p.ab_w_out, (u16*)(ws + OFF_WB_ABOUT), 2048, 2048, 2048, 0, tl);
    {
        u16* Bt = (u16*)(ws + OFF_WB_LORA);
        for (int idx = gtid; idx < 4096 * 512; idx += nth) { const int n = idx >> 9, k = idx & 511; float v = 0.f;
            if (n < 2048) { if (k < 96) v = p.rwkv_w_up[((size_t)(n >> 10) * 96 + k) * 1024 + (n & 1023)]; }
            else if (n < 3072) { if (k >= 96 && k < 192) v = p.rwkv_a_up[(size_t)(k - 96) * 1024 + (n - 2048)]; }
            else { if (k >= 192 && k < 448) v = p.rwkv_g_up[(size_t)(k - 192) * 1024 + (n - 3072)]; }
            Bt[idx] = f2bf(v); }
    }
    {
        float* cs = (float*)(ws + OFF_ROPE); float* sn = cs + 4096 * 32;
        for (int idx = gtid; idx < 4096 * 32; idx += nth) { const int t = idx >> 5, i = idx & 31;
            const float inv = powf(10000.0f, -(float)(2 * i) / 64.0f); const float ang = (float)t * inv;
            const double rev = (double)ang * 0.15915494309189535; const float fr = (float)(rev - rint(rev));
            cs[idx] = __builtin_amdgcn_cosf(fr); sn[idx] = __builtin_amdgcn_sinf(fr); }
    }
}
__device__ __forceinline__ void phase_mods(const Params& p) {
    const float* part = (const float*)(p.ws + OFF_PART); float* mods = (float*)(p.ws + OFF_MODS);
    for (int idx = blockIdx.x * 512 + ltid(); idx < 98304; idx += gridDim.x * 512) {
        const int s = idx / 24576, n = idx % 6144; float a = p.ada_b[s * 6144 + n];
#pragma unroll
        for (int kc = 0; kc < 16; ++kc) a += part[(size_t)kc * 98304 + idx];
        mods[idx] = a; }
}
__device__ __forceinline__ void phase_modulate(const Params& p) {
    const float* mods = (const float*)(p.ws + OFF_MODS); u16* H = (u16*)(p.ws + OFF_H);
    for (int idx = blockIdx.x * 512 + ltid(); idx < 16384 * 512; idx += gridDim.x * 512) {
        const int m = idx >> 9, c = (idx & 511) * 4, b = m >> 12;
        const f32x4 xv = __builtin_nontemporal_load((const f32x4*)(p.x + (size_t)m * 2048 + c)), sh = *(const f32x4*)(mods + b * 6144 + c), scl = *(const f32x4*)(mods + b * 6144 + 2048 + c);
        u32x2 o; o[0] = cvt_pk_bf16(xv[0] * (1.f + scl[0]) + sh[0], xv[1] * (1.f + scl[1]) + sh[1]); o[1] = cvt_pk_bf16(xv[2] * (1.f + scl[2]) + sh[2], xv[3] * (1.f + scl[3]) + sh[3]);
        *(u32x2*)(H + (size_t)m * 2048 + c) = o; }
}

__device__ __forceinline__ void phase_prep(const Params& p, unsigned char* lds) {
    const f16* Z = (const f16*)(p.ws + OFF_Z); u16* L = (u16*)(p.ws + OFF_L);
    const int tid = ltid();
    for (int idx = blockIdx.x * 512 + tid; idx < 16384 * 64; idx += gridDim.x * 512) {
        const int m = idx >> 6, grp = idx & 63, t = m & 4095; u32x4 o = (u32x4){0u, 0u, 0u, 0u};
        if (grp < 56) {
            const int zc = 3072 + 8 * grp; const f16* zp = Z + (size_t)m * ZLD + zc;
            const f16x8 z1 = *(const f16x8*)zp; f16x8 z0, z2;
            if (t > 0) z0 = *(const f16x8*)(zp - ZLD); else { for (int j = 0; j < 8; ++j) z0[j] = (f16)0.f; }
            if (t < 4095) z2 = *(const f16x8*)(zp + ZLD); else { for (int j = 0; j < 8; ++j) z2[j] = (f16)0.f; }
            float v[8];
#pragma unroll
            for (int j = 0; j < 8; ++j) { const float a = (float)z1[j]; const float zs = a + (0.5f * ((float)z0[j] + (float)z2[j]) - a) * p.rwkv_mu[zc + j];
                v[j] = grp < 12 ? tanhf(zs) : (grp < 24 ? zs : sigmoidf_(zs)); }
            o[0] = cvt_pk_bf16(v[0], v[1]); o[1] = cvt_pk_bf16(v[2], v[3]); o[2] = cvt_pk_bf16(v[4], v[5]); o[3] = cvt_pk_bf16(v[6], v[7]);
        }
        *(u32x4*)(L + (size_t)m * 512 + 8 * grp) = o;
    }
    float* sg = (float*)lds;
    u16* QB = (u16*)(p.ws + OFF_H); u16* KB = QB + (size_t)2 * 16384 * 512; float* DEC = (float*)(p.ws + OFF_PART);
    for (int pass = 0; pass < 2; ++pass) {
        const int cmb = tid + 512 * pass, dir = cmb >> 9, d = cmb & 511;
        float gu[16];
#pragma unroll
        for (int r = 0; r < 16; ++r) gu[r] = p.gla_gate_up[((size_t)dir * 16 + r) * 512 + d];
        const float gb = p.gla_gate_b[dir * 512 + d];
        for (int tile = blockIdx.x; tile < 256; tile += gridDim.x) {
            const int m0 = tile * 64;
            { const int tok = tid >> 3, r2 = (tid & 7) * 2; const f16x2 gv = *(const f16x2*)(Z + (size_t)(m0 + tok) * ZLD + 5568 + r2); sg[tok * 16 + r2] = (float)gv[0]; sg[tok * 16 + r2 + 1] = (float)gv[1]; }
            __syncthreads();
            float bsum = 0.f;
            for (int sidx = 0; sidx < 64; ++sidx) { const int tok = dir ? 63 - sidx : sidx; float uu = gb;
#pragma unroll
                for (int r = 0; r < 16; ++r) uu += sg[tok * 16 + r] * gu[r];
                const float ls = fminf(uu, 0.f) - __logf(1.0f + __expf(-fabsf(uu)));
                bsum += ls * 0.0625f;
                const f16* zp = Z + (size_t)(m0 + tok) * ZLD;
                const float qv = (float)zp[3520 + d], kv = (float)zp[4032 + d];
                const size_t o = ((size_t)dir * 16384 + m0 + tok) * 512 + d;
                QB[o] = f2bf(qv * 0.08838834764831845f * __expf(bsum)); KB[o] = f2bf(kv * __expf(-bsum)); }
            DEC[((size_t)dir * 256 + tile) * 512 + d] = __expf(bsum);
            __syncthreads();
        }
    }
}

struct ConvDesc { const float* W; u16* Bt; int K, nsrc, mode, rel; };
__device__ __forceinline__ ConvDesc conv_decode(const Params& p, int pid) {
    ConvDesc d; unsigned char* ws = p.ws;
    if (pid < 22528)      { d.W = p.ffn_w_in;  d.Bt = (u16*)(ws + OFF_WB_FFNIN0);  d.K = 2048; d.nsrc = 11264; d.mode = 1; d.rel = pid; }
    else if (pid < 33792) { d.W = p.ffn_w_out; d.Bt = (u16*)(ws + OFF_WB_FFNOUT0); d.K = 5632; d.nsrc = 2048;  d.mode = 0; d.rel = pid - 22528; }
    else if (pid < 46080) { d.W = p.diff_w_in; d.Bt = (u16*)(ws + OFF_WB_DIN);     d.K = 2048; d.nsrc = 6144;  d.mode = 2; d.rel = pid - 33792; }
    else if (pid < 50176) { d.W = p.diff_w_out; d.Bt = (u16*)(ws + OFF_WB_DOUT);   d.K = 2048; d.nsrc = 2048;  d.mode = 0; d.rel = pid - 46080; }
    else if (pid < 72704) { d.W = p.ffn_w_in + (size_t)2048 * 11264;  d.Bt = (u16*)(ws + OFF_WB_FFNIN1);  d.K = 2048; d.nsrc = 11264; d.mode = 1; d.rel = pid - 50176; }
    else                  { d.W = p.ffn_w_out + (size_t)5632 * 2048;  d.Bt = (u16*)(ws + OFF_WB_FFNOUT1); d.K = 5632; d.nsrc = 2048;  d.mode = 0; d.rel = pid - 72704; }
    return d;
}
constexpr int CONV_PIECES = 83968;
__device__ __forceinline__ void conv_load(const Params& p, int pid, int lane, float (&cv)[16], int& nt, int& kp, u16*& dst) {
    const ConvDesc d = conv_decode(p, pid);
    if (d.rel == 0) { nt = 0; kp = 0; }
    const int src = sigma_map(d.mode, nt * 64 + lane, d.nsrc);
    const float* wp = d.W + (size_t)(16 * kp) * d.nsrc + src;
#pragma unroll
    for (int j = 0; j < 16; ++j) cv[j] = __builtin_nontemporal_load(wp + (size_t)j * d.nsrc);
    dst = d.Bt + (size_t)(nt * 64 + lane) * d.K + 16 * kp;
    ++kp; if (kp == (d.K >> 4)) { kp = 0; ++nt; }
}
__device__ __forceinline__ void conv_store(u16* dst, const float (&cv)[16]) {
    u32x4 o0, o1;
#pragma unroll
    for (int j = 0; j < 4; ++j) { o0[j] = cvt_pk_bf16(cv[2 * j], cv[2 * j + 1]); o1[j] = cvt_pk_bf16(cv[8 + 2 * j], cv[9 + 2 * j]); }
    __builtin_nontemporal_store(o0, (u32x4*)dst); __builtin_nontemporal_store(o1, (u32x4*)(dst + 8));
}
#define SC_BAR() do { asm volatile("s_waitcnt lgkmcnt(0)" ::: "memory"); __builtin_amdgcn_s_barrier(); asm volatile("" ::: "memory"); } while (0)
__device__ __forceinline__ float dpp_sum8(float x) {
    x += __builtin_bit_cast(float, __builtin_amdgcn_update_dpp(0, __builtin_bit_cast(int, x), 0xB1, 0xF, 0xF, true));
    x += __builtin_bit_cast(float, __builtin_amdgcn_update_dpp(0, __builtin_bit_cast(int, x), 0x4E, 0xF, 0xF, true));
    x += __builtin_bit_cast(float, __builtin_amdgcn_update_dpp(0, __builtin_bit_cast(int, x), 0x141, 0xF, 0xF, true));
    return x;
}
__device__ __forceinline__ float afma(float a, float b, float c) { float d; asm("v_fma_f32 %0, %1, %2, %3" : "=v"(d) : "v"(a), "v"(b), "v"(c)); return d; }
__device__ __forceinline__ float amul(float a, float b) { float d; asm("v_mul_f32 %0, %1, %2" : "=v"(d) : "v"(a), "v"(b)); return d; }
struct RwRaw { f16x8 r0, r1, r2, k0, k1, k2, v0, v1, v2, a, w; };
__device__ __forceinline__ int launder_v(int x) { asm volatile("" : "+v"(x)); return x; }
__device__ __forceinline__ void phase_scans(const Params& p, unsigned char* lds) {
    const f16* Z = (const f16*)(p.ws + OFF_Z);
    const int tid = ltid(); const int wv = __builtin_amdgcn_readfirstlane(tid >> 6);
    float* sRW = (float*)lds;
    unsigned char* sGLA = lds + 54272;
    for (int item = blockIdx.x; item < 256; item += gridDim.x) {
        if (wv < 4) {
            const int rh = item & 1;
            const int ct = launder_v(tid); const int rowl = ct >> 3, ksl = ct & 7;
            __builtin_amdgcn_s_setprio(3);
            float S[8];
#pragma unroll
            for (int j = 0; j < 8; ++j) S[j] = 0.f;
            SC_BAR();
            for (int ci = 0; ci < 256; ++ci) {
                const float* bufp = sRW + (ci & 1) * 6656;
                const float* sO = bufp + 4 * ksl; const float* sV = bufp + 5120 + 32 * rh + rowl;
                float* ydst = (ksl == 0) ? ((float*)bufp + 6144 + rowl) : (sRW + 13312 + ct);
                const int ystep = (ksl == 0) ? 32 : 0;
#define RW_OPS(s_, r_, w_, k_, kk_, na_, v_) do { const float* q_ = sO + (s_) * 64; \
                r_[0] = *(const f32x4*)q_; r_[1] = *(const f32x4*)(q_ + 32); w_[0] = *(const f32x4*)(q_ + 1024); w_[1] = *(const f32x4*)(q_ + 1056); k_[0] = *(const f32x4*)(q_ + 2048); k_[1] = *(const f32x4*)(q_ + 2080); \
                kk_[0] = *(const f32x4*)(q_ + 3072); kk_[1] = *(const f32x4*)(q_ + 3104); na_[0] = *(const f32x4*)(q_ + 4096); na_[1] = *(const f32x4*)(q_ + 4128); v_ = sV[(s_) * 64]; } while (0)
                f32x4 r4[2], w4[2], k4[2], kk4[2], na4[2]; float v1;
                RW_OPS(0, r4, w4, k4, kk4, na4, v1);
#pragma unroll 2
                for (int s = 0; s < 16; ++s) {
                    const int sn = (s + 1) & 15;
                    f32x4 r4n[2], w4n[2], k4n[2], kk4n[2], na4n[2]; float v1n;
                    RW_OPS(sn, r4n, w4n, k4n, kk4n, na4n, v1n);
                    float d0 = amul(S[0], kk4[0][0]), d1 = amul(S[4], kk4[1][0]);
#pragma unroll
                    for (int j = 1; j < 4; ++j) { d0 = afma(S[j], kk4[0][j], d0); d1 = afma(S[4 + j], kk4[1][j], d1); }
                    const float d = dpp_sum8(d0 + d1);
#pragma unroll
                    for (int j = 0; j < 4; ++j) {
                        S[j] = afma(v1, k4[0][j], afma(S[j], w4[0][j], amul(d, na4[0][j])));
                        S[4 + j] = afma(v1, k4[1][j], afma(S[4 + j], w4[1][j], amul(d, na4[1][j]))); }
                    float y0 = amul(S[0], r4[0][0]), y1 = amul(S[4], r4[1][0]);
#pragma unroll
                    for (int j = 1; j < 4; ++j) { y0 = afma(S[j], r4[0][j], y0); y1 = afma(S[4 + j], r4[1][j], y1); }
                    const float y = dpp_sum8(y0 + y1);
                    ydst[s * ystep] = y;
#pragma unroll
                    for (int q = 0; q < 2; ++q) { r4[q] = r4n[q]; w4[q] = w4n[q]; k4[q] = k4n[q]; kk4[q] = kk4n[q]; na4[q] = na4n[q]; }
                    v1 = v1n;
                }
#undef RW_OPS
                SC_BAR();
            }
            __builtin_amdgcn_s_setprio(0);
        } else if (wv < 6) {
            const int ptid = launder_v(tid) & 127;
            const f16* WAG = (const f16*)(p.ws + OFF_WAG); f16* YS = (f16*)(p.ws + OFF_YS);
            const int rh = item & 1, hd = item >> 1, h = hd & 15, b = (hd >> 4) & 3, dir = hd >> 6;
            const int tp = ptid >> 3, cg8 = ptid & 7, c0 = 64 * h + 8 * cg8;
            float mu_r[8], mu_k[8], mu_v[8], kkw[8], kaw[8];
#pragma unroll
            for (int j = 0; j < 8; ++j) { mu_r[j] = p.rwkv_mu[c0 + j]; mu_k[j] = p.rwkv_mu[1024 + c0 + j]; mu_v[j] = p.rwkv_mu[2048 + c0 + j]; kkw[j] = p.rwkv_k_k[c0 + j]; kaw[j] = p.rwkv_k_a[c0 + j]; }
            const f16x8 zero8 = {(f16)0.f, (f16)0.f, (f16)0.f, (f16)0.f, (f16)0.f, (f16)0.f, (f16)0.f, (f16)0.f};
            RwRaw A, B;
#define RW_LOAD(X, ci) do { const int n_ = (ci) * 16 + tp; const int t_ = dir ? 4095 - n_ : n_; const size_t m_ = (size_t)b * 4096 + t_; const f16* zp_ = Z + m_ * ZLD + c0; \
            X.r1 = *(const f16x8*)zp_; X.k1 = *(const f16x8*)(zp_ + 1024); X.v1 = *(const f16x8*)(zp_ + 2048); \
            if (t_ > 0) { X.r0 = *(const f16x8*)(zp_ - ZLD); X.k0 = *(const f16x8*)(zp_ - ZLD + 1024); X.v0 = *(const f16x8*)(zp_ - ZLD + 2048); } else { X.r0 = zero8; X.k0 = zero8; X.v0 = zero8; } \
            if (t_ < 4095) { X.r2 = *(const f16x8*)(zp_ + ZLD); X.k2 = *(const f16x8*)(zp_ + ZLD + 1024); X.v2 = *(const f16x8*)(zp_ + ZLD + 2048); } else { X.r2 = zero8; X.k2 = zero8; X.v2 = zero8; } \
            X.a = *(const f16x8*)(WAG + m_ * 4096 + 2048 + c0); X.w = *(const f16x8*)(WAG + m_ * 4096 + 1024 * dir + c0); } while (0)
#define RW_PROC(X, bufp) do { float* sR = (bufp); \
            float rr[8], kp[8], vv[8], kkr[8], av[8], wv_[8]; float ss = 0.f; \
            _Pragma("unroll") for (int j = 0; j < 8; ++j) { \
                const float r1 = (float)X.r1[j], k1 = (float)X.k1[j], v1 = (float)X.v1[j]; \
                rr[j] = r1 + (0.5f * ((float)X.r0[j] + (float)X.r2[j]) - r1) * mu_r[j]; \
                const float kx = k1 + (0.5f * ((float)X.k0[j] + (float)X.k2[j]) - k1) * mu_k[j]; \
                vv[j] = v1 + (0.5f * ((float)X.v0[j] + (float)X.v2[j]) - v1) * mu_v[j]; \
                av[j] = (float)X.a[j]; wv_[j] = 1.0f - (float)X.w[j]; \
                kkr[j] = kx * kkw[j]; ss += kkr[j] * kkr[j]; \
                kp[j] = kx * (1.0f + (av[j] - 1.0f) * kaw[j]); } \
            ss = dpp_sum8(ss); \
            const float inv = __builtin_amdgcn_rsqf(fmaxf(ss, 1e-24f)); \
            const int o = tp * 64 + 4 * cg8; f32x4 t0, t1; \
            _Pragma("unroll") for (int j = 0; j < 4; ++j) { t0[j] = rr[j]; t1[j] = rr[4 + j]; } *(f32x4*)(sR + o) = t0; *(f32x4*)(sR + o + 32) = t1; \
            _Pragma("unroll") for (int j = 0; j < 4; ++j) { t0[j] = wv_[j]; t1[j] = wv_[4 + j]; } *(f32x4*)(sR + 1024 + o) = t0; *(f32x4*)(sR + 1024 + o + 32) = t1; \
            _Pragma("unroll") for (int j = 0; j < 4; ++j) { t0[j] = kp[j]; t1[j] = kp[4 + j]; } *(f32x4*)(sR + 2048 + o) = t0; *(f32x4*)(sR + 2048 + o + 32) = t1; \
            _Pragma("unroll") for (int j = 0; j < 4; ++j) { t0[j] = kkr[j] * inv; t1[j] = kkr[4 + j] * inv; } *(f32x4*)(sR + 3072 + o) = t0; *(f32x4*)(sR + 3072 + o + 32) = t1; \
            _Pragma("unroll") for (int j = 0; j < 4; ++j) { t0[j] = -kkr[j] * inv * av[j]; t1[j] = -kkr[4 + j] * inv * av[4 + j]; } *(f32x4*)(sR + 4096 + o) = t0; *(f32x4*)(sR + 4096 + o + 32) = t1; \
            const int ov = tp * 64 + 8 * cg8; \
            _Pragma("unroll") for (int j = 0; j < 4; ++j) { t0[j] = vv[j]; t1[j] = vv[4 + j]; } *(f32x4*)(sR + 5120 + ov) = t0; *(f32x4*)(sR + 5120 + ov + 4) = t1; } while (0)
#define RW_FLUSH(bufp, ci) do { const float* sY = (bufp) + 6144; const int s_ = ptid >> 3, rr4 = (ptid & 7) * 4; const int n_ = (ci) * 16 + s_; const int t_ = dir ? 4095 - n_ : n_; \
            const f32x4 yv = *(const f32x4*)(sY + s_ * 32 + rr4); f16x4 o_; o_[0] = (f16)yv[0]; o_[1] = (f16)yv[1]; o_[2] = (f16)yv[2]; o_[3] = (f16)yv[3]; \
            __builtin_nontemporal_store(o_, (f16x4*)(YS + ((size_t)dir * 16384 + (size_t)b * 4096 + t_) * 1024 + 64 * h + 32 * rh + rr4)); } while (0)
            RW_LOAD(A, 0); RW_PROC(A, sRW); RW_LOAD(B, 1); RW_LOAD(A, 2);
            SC_BAR();
            for (int ci = 0; ci < 256; ci += 2) {
                if (ci >= 1) RW_FLUSH(sRW + 6656, ci - 1);
                RW_PROC(B, sRW + 6656); if (ci + 3 < 256) RW_LOAD(B, ci + 3);
                SC_BAR();
                RW_FLUSH(sRW, ci);
                if (ci + 2 < 256) { RW_PROC(A, sRW); if (ci + 4 < 256) RW_LOAD(A, ci + 4); }
                SC_BAR();
            }
            RW_FLUSH(sRW + 6656, 255);
#undef RW_LOAD
#undef RW_PROC
#undef RW_FLUSH
        } else {
            const int gt0 = launder_v(tid); const int gw = wv - 6, lane = gt0 & 63, fr = lane & 15, g = lane >> 4;
            const u16* QB = (const u16*)(p.ws + OFF_H); const u16* KB = QB + (size_t)2 * 16384 * 512; const float* DEC = (const float*)(p.ws + OFF_PART);
            f16* OS = (f16*)(p.ws + OFF_OS);
            const int vs = item & 7, seq = item >> 3, h = seq & 3, b = (seq >> 2) & 3, dir = seq >> 4;
            u16* sQ = (u16*)sGLA; u16* sK = (u16*)(sGLA + 17408); u16* sKT = (u16*)(sGLA + 34816); u16* sVT = (u16*)(sGLA + 53248); u16* sST = (u16*)(sGLA + 57856); float* sDEC = (float*)(sGLA + 66560);
            f32x4 Sacc[4][2];
#pragma unroll
            for (int a_ = 0; a_ < 4; ++a_)
#pragma unroll
                for (int b_ = 0; b_ < 2; ++b_) Sacc[a_][b_] = (f32x4){0.f, 0.f, 0.f, 0.f};
            u32x4 rq[8], rk[8]; f16x8 rv[2]; float rdec;
            float cv[16];
            const int nworkers = (int)gridDim.x * 2; const int ppw = (CONV_PIECES + nworkers - 1) / nworkers;
            const int cbeg = __builtin_amdgcn_readfirstlane(item == (int)blockIdx.x ? ((int)blockIdx.x * 2 + gw) * ppw : CONV_PIECES);
            const int cend = cbeg + ppw < CONV_PIECES ? cbeg + ppw : CONV_PIECES;
            int cpid = cbeg, cnt_ = 0, ckp_ = 0; u16* cdst = nullptr;
            if (cbeg < cend) { const ConvDesc d0 = conv_decode(p, cbeg); const int kpn0 = d0.K >> 4; cnt_ = d0.rel / kpn0; ckp_ = d0.rel - cnt_ * kpn0; }
#define CONV_STEP() do { if (cpid > cbeg && cpid <= cend) conv_store(cdst, cv); if (cpid < cend) conv_load(p, cpid, lane, cv, cnt_, ckp_, cdst); if (cpid <= cend) ++cpid; } while (0)
#define GL_LOADG(c) do { const int gtid = launder_v(gt0) & 127; _Pragma("unroll") for (int q_ = 0; q_ < 8; ++q_) { const int id_ = gtid + 128 * q_, row_ = id_ >> 4, c16_ = id_ & 15; \
                const int t_ = dir ? 4095 - (64 * (c) + row_) : 64 * (c) + row_; const size_t o_ = ((size_t)dir * 16384 + (size_t)b * 4096 + t_) * 512 + 128 * h + 8 * c16_; \
                rq[q_] = *(const u32x4*)(QB + o_); rk[q_] = *(const u32x4*)(KB + o_); } \
            _Pragma("unroll") for (int q_ = 0; q_ < 2; ++q_) { const int id_ = gtid + 128 * q_, row_ = id_ >> 2, pt_ = id_ & 3; \
                const int t_ = dir ? 4095 - (64 * (c) + row_) : 64 * (c) + row_; rv[q_] = *(const f16x8*)(Z + ((size_t)b * 4096 + t_) * ZLD + 4544 + 256 * h + 32 * vs + 8 * pt_); } \
            rdec = DEC[((size_t)dir * 256 + b * 64 + (dir ? 63 - (c) : (c))) * 512 + 128 * h + gtid]; } while (0)
            GL_LOADG(0);
            for (int i_ = (gt0 & 127); i_ < 2176; i_ += 128) ((unsigned*)sST)[i_] = 0u;
            SC_BAR();
            for (int c = 0; c < 64; ++c) {
                const int gtid = launder_v(gt0) & 127;
                CONV_STEP();
#pragma unroll
                for (int q_ = 0; q_ < 8; ++q_) { const int id_ = gtid + 128 * q_, row_ = id_ >> 4, c16_ = id_ & 15;
                    *(u32x4*)(sQ + row_ * 136 + 8 * c16_) = rq[q_]; *(u32x4*)(sK + row_ * 136 + 8 * c16_) = rk[q_];
#pragma unroll
                    for (int e = 0; e < 4; ++e) { sKT[(8 * c16_ + 2 * e) * 72 + row_] = (u16)(rk[q_][e] & 0xFFFFu); sKT[(8 * c16_ + 2 * e + 1) * 72 + row_] = (u16)(rk[q_][e] >> 16); } }
#pragma unroll
                for (int q_ = 0; q_ < 2; ++q_) { const int id_ = gtid + 128 * q_, row_ = id_ >> 2, pt_ = id_ & 3;
#pragma unroll
                    for (int e = 0; e < 8; ++e) sVT[(8 * pt_ + e) * 72 + row_] = f2bf((float)rv[q_][e]); }
                sDEC[gtid] = rdec;
                SC_BAR();
                if (c + 1 < 64) GL_LOADG(c + 1);
                CONV_STEP();
#define GL_IT(it) do { \
                    bf16x8 qf[4]; \
                    _Pragma("unroll") for (int ds = 0; ds < 4; ++ds) qf[ds] = *(const bf16x8*)(sQ + (16 * (it) + fr) * 136 + 32 * ds + 8 * g); \
                    f32x4 att[4]; \
                    _Pragma("unroll") for (int jt = 0; jt < 4; ++jt) { att[jt] = (f32x4){0.f, 0.f, 0.f, 0.f}; \
                        if (jt <= (it)) { \
                            _Pragma("unroll") for (int ds = 0; ds < 4; ++ds) { const bf16x8 kf = *(const bf16x8*)(sK + (16 * jt + fr) * 136 + 32 * ds + 8 * g); \
                                att[jt] = __builtin_amdgcn_mfma_f32_16x16x32_bf16(kf, qf[ds], att[jt], 0, 0, 0); } \
                            if (jt == (it)) { _Pragma("unroll") for (int r = 0; r < 4; ++r) att[jt][r] = (4 * g + r <= fr) ? att[jt][r] : 0.f; } } } \
                    bf16x8 pb[2]; \
                    _Pragma("unroll") for (int s2 = 0; s2 < 2; ++s2) { u32x4 pk; pk[0] = cvt_pk_bf16(att[2 * s2][0], att[2 * s2][1]); pk[1] = cvt_pk_bf16(att[2 * s2][2], att[2 * s2][3]); \
                        pk[2] = cvt_pk_bf16(att[2 * s2 + 1][0], att[2 * s2 + 1][1]); pk[3] = cvt_pk_bf16(att[2 * s2 + 1][2], att[2 * s2 + 1][3]); pb[s2] = __builtin_bit_cast(bf16x8, pk); } \
                    _Pragma("unroll") for (int vt = 0; vt < 2; ++vt) { \
                        f32x4 ot = (f32x4){0.f, 0.f, 0.f, 0.f}; \
                        _Pragma("unroll") for (int s2 = 0; s2 < 2; ++s2) { if (2 * s2 <= (it)) { \
                            const u32x2 lo = *(const u32x2*)(sVT + (16 * vt + fr) * 72 + 32 * s2 + 4 * g), hi = *(const u32x2*)(sVT + (16 * vt + fr) * 72 + 32 * s2 + 16 + 4 * g); \
                            u32x4 av; av[0] = lo[0]; av[1] = lo[1]; av[2] = hi[0]; av[3] = hi[1]; \
                            ot = __builtin_amdgcn_mfma_f32_16x16x32_bf16(__builtin_bit_cast(bf16x8, av), pb[s2], ot, 0, 0, 0); } } \
                        _Pragma("unroll") for (int ds = 0; ds < 4; ++ds) { const bf16x8 sf = *(const bf16x8*)(sST + (16 * vt + fr) * 136 + 32 * ds + 8 * g); \
                            ot = __builtin_amdgcn_mfma_f32_16x16x32_bf16(sf, qf[ds], ot, 0, 0, 0); } \
                        const int irow = 16 * (it) + fr; const int t_ = dir ? 4095 - (64 * c + irow) : 64 * c + irow; \
                        f16x4 o_; o_[0] = (f16)ot[0]; o_[1] = (f16)ot[1]; o_[2] = (f16)ot[2]; o_[3] = (f16)ot[3]; \
                        __builtin_nontemporal_store(o_, (f16x4*)(OS + ((size_t)dir * 16384 + (size_t)b * 4096 + t_) * 1024 + 256 * h + 32 * vs + 16 * vt + 4 * g)); } } while (0)
                if (gw == 0) { GL_IT(0); GL_IT(3); } else { GL_IT(1); GL_IT(2); }
#undef GL_IT
                SC_BAR();
                CONV_STEP();
#pragma unroll
                for (int dl = 0; dl < 4; ++dl) { const int dt = 4 * gw + dl;
#pragma unroll
                    for (int vt = 0; vt < 2; ++vt) { f32x4 kv = Sacc[dl][vt];
#pragma unroll
                        for (int s2 = 0; s2 < 2; ++s2) { const bf16x8 af = *(const bf16x8*)(sKT + (16 * dt + fr) * 72 + 32 * s2 + 8 * g), bfv = *(const bf16x8*)(sVT + (16 * vt + fr) * 72 + 32 * s2 + 8 * g);
                            kv = __builtin_amdgcn_mfma_f32_16x16x32_bf16(af, bfv, kv, 0, 0, 0); }
                        const f32x4 dc = *(const f32x4*)(sDEC + 16 * dt + 4 * g);
#pragma unroll
                        for (int r = 0; r < 4; ++r) kv[r] *= dc[r];
                        Sacc[dl][vt] = kv;
                        u32x2 w_; w_[0] = cvt_pk_bf16(kv[0], kv[1]); w_[1] = cvt_pk_bf16(kv[2], kv[3]);
                        *(u32x2*)(sST + (16 * vt + fr) * 136 + 16 * dt + 4 * g) = w_; } }
                SC_BAR();
                CONV_STEP();
                SC_BAR();
            }
            while (cpid <= cend) CONV_STEP();
#undef CONV_STEP
#undef GL_LOADG
        }
        __syncthreads();
    }
}

__device__ __forceinline__ void phase_finalize(const Params& p) {
    const f16* Z = (const f16*)(p.ws + OFF_Z); const f16* WAG = (const f16*)(p.ws + OFF_WAG); const f16* YS = (const f16*)(p.ws + OFF_YS); const f16* OS = (const f16*)(p.ws + OFF_OS);
    u16* YC = (u16*)(p.ws + OFF_H);
    const int gtid = blockIdx.x * 512 + ltid(), nth = gridDim.x * 512;
    const f16x8 zero8 = {(f16)0.f, (f16)0.f, (f16)0.f, (f16)0.f, (f16)0.f, (f16)0.f, (f16)0.f, (f16)0.f};
    const int c0 = 64 * ((gtid >> 3) & 15) + 8 * (gtid & 7);
    float pmu_r[8], pmu_k[8], pmu_v[8], pka[8], prk[8], pgg[8], pgb[8];
#pragma unroll
    for (int j = 0; j < 8; ++j) { pmu_r[j] = p.rwkv_mu[c0 + j]; pmu_k[j] = p.rwkv_mu[1024 + c0 + j]; pmu_v[j] = p.rwkv_mu[2048 + c0 + j]; pka[j] = p.rwkv_k_a[c0 + j]; prk[j] = p.rwkv_r_k[c0 + j];
        pgg[j] = p.rwkv_gn_g[c0 + j]; pgb[j] = p.rwkv_gn_b[c0 + j]; }
    for (int idx = gtid; idx < 16384 * 16 * 8; idx += nth) {
        const int it = idx >> 3, m = it >> 4, t = m & 4095;
        const f16* zp = Z + (size_t)m * ZLD + c0;
        const f16x8 zr1 = *(const f16x8*)zp, zk1 = *(const f16x8*)(zp + 1024), zv1 = *(const f16x8*)(zp + 2048);
        f16x8 zr0 = zero8, zk0 = zero8, zv0 = zero8, zr2 = zero8, zk2 = zero8, zv2 = zero8;
        if (t > 0) { zr0 = *(const f16x8*)(zp - ZLD); zk0 = *(const f16x8*)(zp - ZLD + 1024); zv0 = *(const f16x8*)(zp - ZLD + 2048); }
        if (t < 4095) { zr2 = *(const f16x8*)(zp + ZLD); zk2 = *(const f16x8*)(zp + ZLD + 1024); zv2 = *(const f16x8*)(zp + ZLD + 2048); }
        const f16x8 za = __builtin_nontemporal_load((const f16x8*)(WAG + (size_t)m * 4096 + 2048 + c0)), zg = __builtin_nontemporal_load((const f16x8*)(WAG + (size_t)m * 4096 + 3072 + c0));
        const f16x8 y0 = __builtin_nontemporal_load((const f16x8*)(YS + (size_t)m * 1024 + c0)), y1 = __builtin_nontemporal_load((const f16x8*)(YS + ((size_t)16384 + m) * 1024 + c0));
        float yv[8], vv[8]; float sum = 0.f, bon = 0.f;
#pragma unroll
        for (int j = 0; j < 8; ++j) {
            const float r1 = (float)zr1[j], k1 = (float)zk1[j], v1 = (float)zv1[j];
            const float rr = r1 + (0.5f * ((float)zr0[j] + (float)zr2[j]) - r1) * pmu_r[j];
            const float kx = k1 + (0.5f * ((float)zk0[j] + (float)zk2[j]) - k1) * pmu_k[j];
            vv[j] = v1 + (0.5f * ((float)zv0[j] + (float)zv2[j]) - v1) * pmu_v[j];
            const float kp = kx * (1.0f + ((float)za[j] - 1.0f) * pka[j]);
            bon += rr * kp * prk[j];
            yv[j] = (float)y0[j] + (float)y1[j]; sum += yv[j];
        }
        sum += __shfl_xor(sum, 1); sum += __shfl_xor(sum, 2); sum += __shfl_xor(sum, 4);
        bon += __shfl_xor(bon, 1); bon += __shfl_xor(bon, 2); bon += __shfl_xor(bon, 4);
        const float mean = sum * (1.0f / 64.0f); float sq = 0.f;
#pragma unroll
        for (int j = 0; j < 8; ++j) { const float d = yv[j] - mean; sq += d * d; }
        sq += __shfl_xor(sq, 1); sq += __shfl_xor(sq, 2); sq += __shfl_xor(sq, 4);
        const float rs = rsqrtf(sq * (1.0f / 64.0f) + 64e-5f);
        float ov[8];
#pragma unroll
        for (int j = 0; j < 8; ++j) { const float yn = (yv[j] - mean) * rs * pgg[j] + pgb[j]; ov[j] = (yn + bon * vv[j]) * (float)zg[j]; }
        u32x4 o; o[0] = cvt_pk_bf16(ov[0], ov[1]); o[1] = cvt_pk_bf16(ov[2], ov[3]); o[2] = cvt_pk_bf16(ov[4], ov[5]); o[3] = cvt_pk_bf16(ov[6], ov[7]);
        *(u32x4*)(YC + (size_t)m * 2048 + c0) = o;
    }
    float png[8];
#pragma unroll
    for (int j = 0; j < 8; ++j) png[j] = p.gla_norm_g[8 * (gtid & 31) + j];
    for (int idx = gtid; idx < 16384 * 4 * 32; idx += nth) {
        const int cg = idx & 31, it = idx >> 5, h = it & 3, m = it >> 2, c0 = 256 * h + 8 * cg;
        const f16x8 o0 = __builtin_nontemporal_load((const f16x8*)(OS + (size_t)m * 1024 + c0)), o1 = __builtin_nontemporal_load((const f16x8*)(OS + ((size_t)16384 + m) * 1024 + c0));
        const f16x8 og = __builtin_nontemporal_load((const f16x8*)(Z + (size_t)m * ZLD + 5584 + c0));
        float ov[8]; float sq = 0.f;
#pragma unroll
        for (int j = 0; j < 8; ++j) { ov[j] = (float)o0[j] + (float)o1[j]; sq += ov[j] * ov[j]; }
        sq += __shfl_xor(sq, 1); sq += __shfl_xor(sq, 2); sq += __shfl_xor(sq, 4); sq += __shfl_xor(sq, 8); sq += __shfl_xor(sq, 16);
        const float rs = rsqrtf(sq * (1.0f / 256.0f) + 1e-5f);
        float r[8];
#pragma unroll
        for (int j = 0; j < 8; ++j) { const float gg = (float)og[j]; r[j] = ov[j] * rs * png[j] * (gg * sigmoidf_(gg)); }
        u32x4 o; o[0] = cvt_pk_bf16(r[0], r[1]); o[1] = cvt_pk_bf16(r[2], r[3]); o[2] = cvt_pk_bf16(r[4], r[5]); o[3] = cvt_pk_bf16(r[6], r[7]);
        *(u32x4*)(YC + (size_t)m * 2048 + 1024 + c0) = o;
    }
}

__device__ __forceinline__ void phase_ln(const Params& p, int s) {
    const float* xin = s == 0 ? p.x : p.out; const f16* Y = (const f16*)(p.ws + OFF_WAG);
    const float* mods = (const float*)(p.ws + OFF_MODS); u16* H = (u16*)(p.ws + OFF_H);
    const float* lg = p.ln_g + s * 2048; const float* lb = p.ln_b + s * 2048;
    const int wid = ltid() >> 6, lane = ltid() & 63;
    for (int row = blockIdx.x * 8 + wid; row < 16384; row += gridDim.x * 8) {
        const int b = row >> 12; const float* gate = mods + (size_t)s * 24576 + b * 6144 + 4096;
        f32x4 v[8]; float sum = 0.f;
#pragma unroll
        for (int i = 0; i < 8; ++i) { const int c = i * 256 + lane * 4;
            const f32x4 xv = __builtin_nontemporal_load((const f32x4*)(xin + (size_t)row * 2048 + c)), gt = *(const f32x4*)(gate + c); const f16x4 yv = __builtin_nontemporal_load((const f16x4*)(Y + (size_t)row * 2048 + c));
#pragma unroll
            for (int j = 0; j < 4; ++j) { v[i][j] = ALPHA_C * xv[j] + (1.0f + gt[j]) * (float)yv[j]; sum += v[i][j]; } }
        sum = wave_sum(sum); const float mean = sum * (1.0f / 2048.0f); float sq = 0.f;
#pragma unroll
        for (int i = 0; i < 8; ++i)
#pragma unroll
            for (int j = 0; j < 4; ++j) { const float d = v[i][j] - mean; sq += d * d; }
        sq = wave_sum(sq); const float rs = rsqrtf(sq * (1.0f / 2048.0f) + 1e-5f);
#pragma unroll
        for (int i = 0; i < 8; ++i) { const int c = i * 256 + lane * 4; const f32x4 g4 = *(const f32x4*)(lg + c), b4 = *(const f32x4*)(lb + c); f32x4 xn;
#pragma unroll
            for (int j = 0; j < 4; ++j) xn[j] = (v[i][j] - mean) * rs * g4[j] + b4[j];
            __builtin_nontemporal_store(xn, (f32x4*)(p.out + (size_t)row * 2048 + c));
            if (s < 3) { const float* mn = mods + (size_t)(s + 1) * 24576 + b * 6144; const f32x4 sh = *(const f32x4*)(mn + c), scl = *(const f32x4*)(mn + 2048 + c);
                u32x2 o; o[0] = cvt_pk_bf16(xn[0] * (1.f + scl[0]) + sh[0], xn[1] * (1.f + scl[1]) + sh[1]); o[1] = cvt_pk_bf16(xn[2] * (1.f + scl[2]) + sh[2], xn[3] * (1.f + scl[3]) + sh[3]);
                *(u32x2*)(H + (size_t)row * 2048 + c) = o; } }
    }
}

__device__ __forceinline__ void phase_attn(const Params& p, unsigned char* lds) {
    const u16* QK = (const u16*)(p.ws + OFF_Z); const u16* VT = (const u16*)(p.ws + OFF_VT); u16* O = (u16*)(p.ws + OFF_YS);
    const int tid = ltid(), wid = tid >> 6, lane = tid & 63, cmap = wid >> 2, qsub = wid & 3, ql = lane & 31, g = lane >> 5;
    float lam;
    { const float a = p.diff_lambda[lane] * p.diff_lambda[64 + lane], bq = p.diff_lambda[128 + lane] * p.diff_lambda[192 + lane];
      lam = __expf(wave_sum(a)) - __expf(wave_sum(bq)) + LINIT; }
    u16* sKt = (u16*)lds;
    u16* sVt = (u16*)(lds + 34816);
    float* ex = (float*)lds;
    const int pql = (ql & ~12) | ((ql & 4) << 1) | ((ql & 8) >> 1);
    for (int unit = blockIdx.x; unit < 2048; unit += gridDim.x) {
        int qb = unit & 31, bh = unit >> 5;
        if (gridDim.x == 256) { bh = (unit >> 8) * 8 + (blockIdx.x & 7); qb = blockIdx.x >> 3; }
        const int h = bh & 15, b = bh >> 4;
        const size_t qrow = (size_t)b * 4096 + 128 * qb + 32 * qsub + ql;
        bf16x8 Qr[4];
#pragma unroll
        for (int ks = 0; ks < 4; ++ks) Qr[ks] = *(const bf16x8*)(QK + qrow * 4096 + 128 * h + 64 * cmap + 16 * ks + 8 * g);
        f32x16 ot[4];
#pragma unroll
        for (int vb = 0; vb < 4; ++vb)
#pragma unroll
            for (int i = 0; i < 16; ++i) ot[vb][i] = 0.f;
        float mrun = -1e30f, lsum = 0.f;
        const u16* kbase = QK + (size_t)b * 4096 * 4096 + 2048 + 128 * h;
        const u16* vbase = VT + (size_t)(b * 16 + h) * 128 * 4096;
        u32x4 kr[2], vr[2];
#define AT_LOADK(kt) do { _Pragma("unroll") for (int i_ = 0; i_ < 2; ++i_) { const int id_ = tid + 512 * i_; \
            kr[i_] = *(const u32x4*)(kbase + (size_t)((kt) * 64 + (id_ >> 4)) * 4096 + (id_ & 15) * 8); } } while (0)
#define AT_LOADV(kt) do { _Pragma("unroll") for (int i_ = 0; i_ < 2; ++i_) { const int id_ = tid + 512 * i_; \
            vr[i_] = *(const u32x4*)(vbase + (size_t)(id_ >> 3) * 4096 + (kt) * 64 + (id_ & 7) * 8); } } while (0)
#define AT_STOREK(buf) do { _Pragma("unroll") for (int i_ = 0; i_ < 2; ++i_) { const int id_ = tid + 512 * i_; \
            *(u32x4*)(sKt + (buf) * 8704 + (id_ >> 4) * 136 + (id_ & 15) * 8) = kr[i_]; } } while (0)
#define AT_STOREV(buf) do { _Pragma("unroll") for (int i_ = 0; i_ < 2; ++i_) { const int id_ = tid + 512 * i_; \
            *(u32x4*)(sVt + (buf) * 9216 + (id_ >> 3) * 72 + (id_ & 7) * 8) = vr[i_]; } } while (0)
#define AT_QK(dst, buf) do { bf16x8 kf_[2][4]; \
            _Pragma("unroll") for (int ks = 0; ks < 4; ++ks) kf_[0][ks] = *(const bf16x8*)(sKt + (buf) * 8704 + pql * 136 + 64 * cmap + 16 * ks + 8 * g); \
            _Pragma("unroll") for (int kb = 0; kb < 2; ++kb) { \
                if (kb == 0) { _Pragma("unroll") for (int ks = 0; ks < 4; ++ks) kf_[1][ks] = *(const bf16x8*)(sKt + (buf) * 8704 + (32 + pql) * 136 + 64 * cmap + 16 * ks + 8 * g); } \
                __builtin_amdgcn_sched_barrier(0); \
                _Pragma("unroll") for (int i = 0; i < 16; ++i) dst[kb][i] = 0.f; \
                __builtin_amdgcn_s_setprio(2); \
                _Pragma("unroll") for (int ks = 0; ks < 4; ++ks) dst[kb] = __builtin_amdgcn_mfma_f32_32x32x16_bf16(kf_[kb][ks], Qr[ks], dst[kb], 0, 0, 0); \
                __builtin_amdgcn_s_setprio(0); \
                __builtin_amdgcn_sched_barrier(0); } } while (0)
        const int toff = 2 * qb;
        AT_LOADK(toff & 63); AT_LOADV(toff & 63); AT_STOREK(0); AT_STOREV(0);
        __syncthreads();
        f32x16 st[2];
        for (int kt = 0; kt < 64; ++kt) {
            const int buf = kt & 1;
            if (kt + 1 < 64) { AT_LOADK((kt + 1 + toff) & 63); AT_LOADV((kt + 1 + toff) & 63); }
            AT_QK(st, buf);
            float mloc = st[0][0];
#pragma unroll
            for (int i = 0; i < 16; ++i) { mloc = fmaxf(mloc, st[0][i]); mloc = fmaxf(mloc, st[1][i]); }
            mloc = fmaxf(mloc, __shfl_xor(mloc, 32));
            const float mnew = fmaxf(mrun, mloc);
            if (__builtin_amdgcn_ballot_w64(mnew > mrun) != 0ull) {
                const float alpha = __builtin_amdgcn_exp2f(mrun - mnew);
                lsum *= alpha;
#pragma unroll
                for (int vb = 0; vb < 4; ++vb)
#pragma unroll
                    for (int i = 0; i < 16; ++i) ot[vb][i] *= alpha;
            }
            mrun = mnew;
            bf16x8 P[2][2];
#pragma unroll
            for (int kb = 0; kb < 2; ++kb)
#pragma unroll
                for (int s2 = 0; s2 < 2; ++s2) { u32x4 pk;
#pragma unroll
                    for (int jj = 0; jj < 4; ++jj) { const float p0 = __builtin_amdgcn_exp2f(st[kb][8 * s2 + 2 * jj] - mnew), p1 = __builtin_amdgcn_exp2f(st[kb][8 * s2 + 2 * jj + 1] - mnew); lsum += p0 + p1; pk[jj] = cvt_pk_bf16(p0, p1); }
                    P[kb][s2] = __builtin_bit_cast(bf16x8, pk); }
            {
                bf16x8 vf[2][4];
#define AT_LDV(set, vb) do { _Pragma("unroll") for (int kb = 0; kb < 2; ++kb) _Pragma("unroll") for (int s2 = 0; s2 < 2; ++s2) \
                    vf[set][kb * 2 + s2] = *(const bf16x8*)(sVt + buf * 9216 + (32 * (vb) + ql) * 72 + 32 * kb + 16 * s2 + 8 * g); } while (0)
                AT_LDV(0, 0);
#pragma unroll
                for (int vb = 0; vb < 4; ++vb) {
                    if (vb < 3) AT_LDV((vb + 1) & 1, vb + 1);
                    __builtin_amdgcn_sched_barrier(0);
                    __builtin_amdgcn_s_setprio(2);
#pragma unroll
                    for (int kb = 0; kb < 2; ++kb)
#pragma unroll
                        for (int s2 = 0; s2 < 2; ++s2) ot[vb] = __builtin_amdgcn_mfma_f32_32x32x16_bf16(vf[vb & 1][kb * 2 + s2], P[kb][s2], ot[vb], 0, 0, 0);
                    __builtin_amdgcn_s_setprio(0);
                    __builtin_amdgcn_sched_barrier(0);
                }
#undef AT_LDV
            }
            if (kt + 1 < 64) { AT_STOREK(buf ^ 1); AT_STOREV(buf ^ 1); }
            __syncthreads();
        }
#undef AT_LOADK
#undef AT_LOADV
#undef AT_STOREK
#undef AT_STOREV
#undef AT_QK
        lsum += __shfl_xor(lsum, 32);
        const float inv = 1.0f / lsum;
        if (cmap == 1) {
#pragma unroll
            for (int vb = 0; vb < 4; ++vb)
#pragma unroll
                for (int i = 0; i < 16; ++i) ex[(vb * 16 + i) * 256 + qsub * 64 + lane] = ot[vb][i] * inv;
        }
        __syncthreads();
        if (cmap == 0) {
            float sq = 0.f;
#pragma unroll
            for (int vb = 0; vb < 4; ++vb)
#pragma unroll
                for (int i = 0; i < 16; ++i) { const float o = ot[vb][i] * inv - lam * ex[(vb * 16 + i) * 256 + qsub * 64 + lane]; ot[vb][i] = o; sq += o * o; }
            sq += __shfl_xor(sq, 32);
            const float rs = rsqrtf(sq * (1.0f / 128.0f) + 1e-5f) * (1.0f - LINIT);
            u16* orow = O + qrow * 2048 + 128 * h;
#pragma unroll
            for (int vb = 0; vb < 4; ++vb)
#pragma unroll
                for (int i4 = 0; i4 < 4; ++i4) { const int v0 = 32 * vb + 8 * i4 + 4 * g; const f32x4 sg = *(const f32x4*)(p.diff_subln_g + v0);
                    u32x2 o; o[0] = cvt_pk_bf16(ot[vb][4 * i4] * rs * sg[0], ot[vb][4 * i4 + 1] * rs * sg[1]); o[1] = cvt_pk_bf16(ot[vb][4 * i4 + 2] * rs * sg[2], ot[vb][4 * i4 + 3] * rs * sg[3]);
                    *(u32x2*)(orow + v0) = o; }
        }
        __syncthreads();
    }
}

#define XB_TMO      128
#define XB_XCNT(j)  (256  + 64 * (j))
#define XB_XSUB(j)  (1280 + 64 * (j))
#define XB_XGEN(j)  (2304 + 64 * (j))
#define XB_TOP      3328
#define XB_TOPGEN   3392
#define XCD_BAR_WORDS 3456
#define XB_SPIN_CAP (1u << 18)
__device__ __forceinline__ unsigned xb_ld(unsigned* p)              { return __hip_atomic_load(p, __ATOMIC_RELAXED, __HIP_MEMORY_SCOPE_AGENT); }
__device__ __forceinline__ unsigned xb_add(unsigned* p, unsigned v) { return __hip_atomic_fetch_add(p, v, __ATOMIC_RELAXED, __HIP_MEMORY_SCOPE_AGENT); }
__device__ __forceinline__ unsigned xb_xcc_id() { return (unsigned)__builtin_amdgcn_s_getreg((3 << 11) | 20) & 0xFu; }
#define XB_SPIN(cond, bar) do { unsigned _sp = 0; while (cond) { __builtin_amdgcn_s_sleep(1); \
    if ((++_sp & 255u) == 0u) { if (xb_ld(&(bar)[XB_TMO])) break; if (_sp > XB_SPIN_CAP) { atomicAdd(&(bar)[XB_TMO], 1u); break; } } } } while (0)
__device__ __forceinline__ void xcd_barrier_complete(unsigned* bar, unsigned x, unsigned& nloc, unsigned& nx) {
    const unsigned G = gridDim.x;
    unsigned sum, cnt, mine, sp = 0u;
    for (;;) {
        sum = 0u; cnt = 0u; mine = 0u;
#pragma unroll
        for (unsigned j = 0; j < 16; ++j) { const unsigned c = xb_ld(&bar[XB_XCNT(j)]); sum += c; cnt += (c > 0u) ? 1u : 0u; mine = (j == x) ? c : mine; }
        if (sum == G) break;
        __builtin_amdgcn_s_sleep(1);
        if ((++sp & 255u) == 0u) { if (xb_ld(&bar[XB_TMO])) break; if (sp > XB_SPIN_CAP) { atomicAdd(&bar[XB_TMO], 1u); break; } }
    }
    nloc = mine > 0u ? mine : 1u; nx = cnt > 0u ? cnt : 1u;
}
__device__ __forceinline__ void xcd_barrier(unsigned* bar, volatile unsigned* st) {
    asm volatile("s_waitcnt vmcnt(0)" ::: "memory");
    __syncthreads();
    if (threadIdx.x == 0) {
        const unsigned x = xb_xcc_id();
        __builtin_amdgcn_s_waitcnt(0);
        unsigned nloc = st[0], nx = st[1];
        if (nloc == 0u) { xcd_barrier_complete(bar, x, nloc, nx); st[0] = nloc; st[1] = nx; }
        const unsigned old = xb_add(&bar[XB_XSUB(x)], 1u);
        const unsigned gen = old / nloc;
        if (old + 1u == (gen + 1u) * nloc) {
            __builtin_amdgcn_fence(__ATOMIC_RELEASE, "agent");
            asm volatile("s_waitcnt vmcnt(0)" ::: "memory");
            const unsigned og = xb_add(&bar[XB_TOP], 1u);
            const unsigned tg = og / nx;
            if (og + 1u == (tg + 1u) * nx) xb_add(&bar[XB_TOPGEN], 1u);
            else XB_SPIN(xb_ld(&bar[XB_TOPGEN]) == tg, bar);
            __builtin_amdgcn_fence(__ATOMIC_ACQUIRE, "agent");
            xb_add(&bar[XB_XGEN(x)], 1u);
            asm volatile("s_waitcnt vmcnt(0)" ::: "memory");
        } else {
            XB_SPIN(xb_ld(&bar[XB_XGEN(x)]) == gen, bar);
            __builtin_amdgcn_fence(__ATOMIC_ACQUIRE, "agent");
            asm volatile("s_waitcnt vmcnt(0)" ::: "memory");
        }
    }
    __syncthreads();
}

__device__ __forceinline__ void run_phase(const Params& p, int ph, unsigned char* lds) {
    unsigned char* ws = p.ws;
    switch (ph) {
    case 0: phase0(p, lds); break;
    case 1: phase_mods(p); break;
    case 2: phase_modulate(p); break;
    case 3: { EpiF16 E; E.O = (f16*)(ws + OFF_Z); E.ldc = ZLD; run_gemm(lds, (const u16*)(ws + OFF_H), (const u16*)(ws + OFF_WB_ABIN), 6656, 2048, E); } break;
    case 4: phase_prep(p, lds); break;
    case 5: { EpiWAG E; E.O = (f16*)(ws + OFF_WAG); E.w0 = p.rwkv_w0; E.a0 = p.rwkv_a0; run_gemm(lds, (const u16*)(ws + OFF_L), (const u16*)(ws + OFF_WB_LORA), 4096, 512, E); } break;
    case 6: phase_scans(p, lds); break;
    case 7: phase_finalize(p); break;
    case 8: case 11: case 15: case 18: {
        const u16* A; const u16* Bt; int K;
        if (ph == 8) { A = (const u16*)(ws + OFF_H); Bt = (const u16*)(ws + OFF_WB_ABOUT); K = 2048; }
        else if (ph == 11) { A = (const u16*)(ws + OFF_Z); Bt = (const u16*)(ws + OFF_WB_FFNOUT0); K = 5632; }
        else if (ph == 15) { A = (const u16*)(ws + OFF_YS); Bt = (const u16*)(ws + OFF_WB_DOUT); K = 2048; }
        else { A = (const u16*)(ws + OFF_Z); Bt = (const u16*)(ws + OFF_WB_FFNOUT1); K = 5632; }
        EpiF16 E; E.O = (f16*)(ws + OFF_WAG); E.ldc = 2048; run_gemm(lds, A, Bt, 2048, K, E); } break;
    case 9: case 12: case 16: case 19: phase_ln(p, ph == 9 ? 0 : (ph == 12 ? 1 : (ph == 16 ? 2 : 3))); break;
    case 10: case 17: { EpiSwiGLU E; E.O = (u16*)(ws + OFF_Z); run_gemm(lds, (const u16*)(ws + OFF_H), (const u16*)(ws + (ph == 10 ? OFF_WB_FFNIN0 : OFF_WB_FFNIN1)), 11264, 2048, E); } break;
    case 13: { EpiQKV E; E.QK = (u16*)(ws + OFF_Z); E.VT = (u16*)(ws + OFF_VT); E.cs = (const float*)(ws + OFF_ROPE); E.sn = E.cs + 4096 * 32;
               run_gemm(lds, (const u16*)(ws + OFF_H), (const u16*)(ws + OFF_WB_DIN), 6144, 2048, E); } break;
    case 14: phase_attn(p, lds); break;
    default: break;
    }
}

#if !MK_SINGLE
__global__ void __launch_bounds__(512, 2) k_phase(Params p, int ph) {
    extern __shared__ __attribute__((aligned(16))) unsigned char shm[];
    run_phase(p, ph, shm);
}
#else
__global__ void __launch_bounds__(512) __attribute__((amdgpu_waves_per_eu(2, 2))) k_mega(Params p) {
    extern __shared__ __attribute__((aligned(16))) unsigned char shm[];
    cg::grid_group grid = cg::this_grid();
    volatile unsigned* xst = (volatile unsigned*)(shm + 131072);
    if (threadIdx.x == 0) { xst[0] = 0u; xst[1] = 0u; (void)xb_add(&((unsigned*)(p.ws + OFF_BAR))[XB_XCNT(xb_xcc_id())], 1u); }
    __syncthreads();
#define PH(n) run_phase(p, n, shm); xcd_barrier((unsigned*)(p.ws + OFF_BAR), (volatile unsigned*)(shm + 131072));
    run_phase(p, 0, shm); grid.sync();
    PH(1) PH(2) PH(3) PH(4) PH(5) PH(6) PH(7) PH(8) PH(9) PH(10) PH(11) PH(12) PH(13) PH(14) PH(15) PH(16) PH(17) PH(18)
#undef PH
    run_phase(p, 19, shm);
}
#endif

extern "C" void kernel_launch(void* const* d_in, const int* in_sizes, int n_in, void* d_out, int out_size, void* d_ws, size_t ws_size, hipStream_t stream) {
    if (ws_size < WS_TOTAL) { fprintf(stderr, "workspace too small: %zu < %zu\n", ws_size, (size_t)WS_TOTAL); return; }
    Params p{};
    const float** pp = (const float**)&p;
    for (int i = 0; i < 28; ++i) pp[i] = (const float*)d_in[i];
    p.out = (float*)d_out; p.ws = (unsigned char*)d_ws;
    constexpr size_t kDynLds = 131072 + 256;
#if MK_SINGLE
    static int grid_blocks = 0;
    if (!grid_blocks) {
        hipFuncSetAttribute((const void*)k_mega, hipFuncAttributeMaxDynamicSharedMemorySize, (int)kDynLds);
        int dev = 0, cus = 0, per_cu = 0;
        hipGetDevice(&dev);
        hipDeviceGetAttribute(&cus, hipDeviceAttributeMultiprocessorCount, dev);
        hipOccupancyMaxActiveBlocksPerMultiprocessor(&per_cu, k_mega, 512, kDynLds);
        grid_blocks = cus * per_cu; if (grid_blocks > 256) grid_blocks = 256;
    }
    (void)hipMemsetAsync((unsigned char*)d_ws + OFF_BAR, 0, 16384, stream);
    void* args[] = {&p};
    hipError_t e = hipLaunchCooperativeKernel((void*)k_mega, dim3(grid_blocks), dim3(512), args, kDynLds, stream);
    if (e != hipSuccess) fprintf(stderr, "cooperative launch failed: %s (grid %d)\n", hipGetErrorString(e), grid_blocks);
#else
    static int inited = 0;
    if (!inited) { hipFuncSetAttribute((const void*)k_phase, hipFuncAttributeMaxDynamicSharedMemorySize, (int)kDynLds); inited = 1; }
    for (int ph = 0; ph < NPHASE; ++ph) k_phase<<<256, 512, kDynLds, stream>>>(p, ph);
#endif
}
```

```cpp
#include <hip/hip_runtime.h>
#include <hip/hip_cooperative_groups.h>
#include <cstdio>
namespace cg = cooperative_groups;

#ifndef MK_SINGLE
#define MK_SINGLE 1
#endif

#define LAS __attribute__((address_space(3)))
typedef unsigned short u16;
typedef _Float16 f16;
typedef short bf16x8 __attribute__((ext_vector_type(8)));
typedef float f32x4 __attribute__((ext_vector_type(4)));
typedef float f32x16 __attribute__((ext_vector_type(16)));
typedef float f32x2 __attribute__((ext_vector_type(2)));
typedef _Float16 f16x8 __attribute__((ext_vector_type(8)));
typedef _Float16 f16x4 __attribute__((ext_vector_type(4)));
typedef _Float16 f16x2 __attribute__((ext_vector_type(2)));
typedef unsigned u32x4 __attribute__((ext_vector_type(4)));
typedef unsigned u32x2 __attribute__((ext_vector_type(2)));

constexpr int ZLD = 6656;
constexpr float ALPHA_C = 1.41421356237f;
constexpr float LINIT = 0.35550906759f;
constexpr int NPHASE = 20;

constexpr size_t OFF_WB_ABIN = 0;
constexpr size_t OFF_WB_LORA = OFF_WB_ABIN + (size_t)6656 * 2048 * 2;
constexpr size_t OFF_WB_ABOUT = OFF_WB_LORA + (size_t)4096 * 512 * 2;
constexpr size_t OFF_WB_FFNIN0 = OFF_WB_ABOUT + (size_t)2048 * 2048 * 2;
constexpr size_t OFF_WB_FFNIN1 = OFF_WB_FFNIN0 + (size_t)11264 * 2048 * 2;
constexpr size_t OFF_WB_FFNOUT0 = OFF_WB_FFNIN1 + (size_t)11264 * 2048 * 2;
constexpr size_t OFF_WB_FFNOUT1 = OFF_WB_FFNOUT0 + (size_t)2048 * 5632 * 2;
constexpr size_t OFF_WB_DIN = OFF_WB_FFNOUT1 + (size_t)2048 * 5632 * 2;
constexpr size_t OFF_WB_DOUT = OFF_WB_DIN + (size_t)6144 * 2048 * 2;
constexpr size_t OFF_PART = OFF_WB_DOUT + (size_t)2048 * 2048 * 2;
constexpr size_t OFF_MODS = OFF_PART + (size_t)16 * 98304 * 4;
constexpr size_t OFF_ROPE = OFF_MODS + (size_t)98304 * 4;
constexpr size_t OFF_H = OFF_ROPE + (size_t)2 * 4096 * 32 * 4;
constexpr size_t OFF_Z = OFF_H + (size_t)16384 * 2048 * 2;
constexpr size_t OFF_L = OFF_Z + (size_t)16384 * 6656 * 2;
constexpr size_t OFF_WAG = OFF_L + (size_t)16384 * 512 * 2;
constexpr size_t OFF_YS = OFF_WAG + (size_t)16384 * 4096 * 2;
constexpr size_t OFF_OS = OFF_YS + (size_t)2 * 16384 * 1024 * 2;
constexpr size_t OFF_BAR = OFF_OS + (size_t)2 * 16384 * 1024 * 2;
constexpr size_t WS_TOTAL = OFF_BAR + 16384;
constexpr size_t OFF_VT = OFF_Z + (size_t)16384 * 4096 * 2;

struct Params {
    const float *x, *c, *ada_w, *ada_b, *ln_g, *ln_b, *ffn_w_in, *ffn_w_out, *ab_w_in, *ab_w_out;
    const float *rwkv_mu, *rwkv_w0, *rwkv_w_up, *rwkv_a0, *rwkv_a_up, *rwkv_g_up, *rwkv_k_k, *rwkv_k_a, *rwkv_r_k, *rwkv_gn_g, *rwkv_gn_b;
    const float *gla_gate_up, *gla_gate_b, *gla_norm_g, *diff_w_in, *diff_w_out, *diff_lambda, *diff_subln_g;
    float* out;
    unsigned char* ws;
};

__device__ __forceinline__ int ltid() { int t = (int)threadIdx.x; asm volatile("" : "+v"(t)); return t; }
__device__ __forceinline__ u16 f2bf(float f) { unsigned u = __float_as_uint(f); u += 0x7FFFu + ((u >> 16) & 1u); return (u16)(u >> 16); }
__device__ __forceinline__ unsigned cvt_pk_bf16(float lo, float hi) { unsigned r; asm volatile("v_cvt_pk_bf16_f32 %0, %1, %2" : "=v"(r) : "v"(lo), "v"(hi)); return r; }
__device__ __forceinline__ float sigmoidf_(float x) { return 1.0f / (1.0f + __expf(-x)); }
__device__ __forceinline__ float dpp_sum16(float x) {
    x += __builtin_bit_cast(float, __builtin_amdgcn_update_dpp(0, __builtin_bit_cast(int, x), 0xB1, 0xF, 0xF, true));
    x += __builtin_bit_cast(float, __builtin_amdgcn_update_dpp(0, __builtin_bit_cast(int, x), 0x4E, 0xF, 0xF, true));
    x += __builtin_bit_cast(float, __builtin_amdgcn_update_dpp(0, __builtin_bit_cast(int, x), 0x141, 0xF, 0xF, true));
    x += __builtin_bit_cast(float, __builtin_amdgcn_update_dpp(0, __builtin_bit_cast(int, x), 0x140, 0xF, 0xF, true));
    return x;
}
__device__ __forceinline__ float wave_sum(float x) {
    x = dpp_sum16(x);
    const float s0 = __uint_as_float(__builtin_amdgcn_readlane(__float_as_uint(x), 0)), s1 = __uint_as_float(__builtin_amdgcn_readlane(__float_as_uint(x), 16));
    const float s2 = __uint_as_float(__builtin_amdgcn_readlane(__float_as_uint(x), 32)), s3 = __uint_as_float(__builtin_amdgcn_readlane(__float_as_uint(x), 48));
    return (s0 + s1) + (s2 + s3);
}

namespace pg8 {
constexpr int BM = 256, BK = 64, HALF = 128, HTB = HALF * BK * 2, STAGE_BYTES = 8 * HTB, NXCD = 8, WGM = 8;
__host__ __device__ __forceinline__ int lds_byte(int r, int c) { const int st = (r >> 4) * 2 + (c >> 5), rr = r & 15, cc = c & 31, ob = rr * 64 + cc * 2; return st * 1024 + (ob ^ (((ob >> 9) & 1) << 5)); }
__host__ __device__ __forceinline__ void stage_rc(int b, int& R, int& C) { const int st = b / 1024, sb = b % 1024, swz = sb ^ (((sb >> 9) & 1) << 5); R = (st >> 1) * 16 + swz / 64; C = (st & 1) * 32 + (swz % 64) / 2; }
__host__ __device__ __forceinline__ int perm32(int rho) { const int n = rho >> 4, i = rho & 15; return 8 * (i >> 2) + 4 * n + (i & 3); }
struct Unit { int pm, pn; };
struct Gemm { const u16* A; const u16* Bt; int M, N, K; };
struct StaticOrder {
    int nM, nN, nwg, G, c;
    __device__ void init(int M, int N, int G_, int c_) { nM = M / BM; nN = N / BM; nwg = nM * nN; G = G_; c = c_; }
    __device__ bool next(int i, Unit& u) const {
        const long L = (long)i * G + c; if (L >= nwg) return false;
        int wgid = (int)L; { const int q = nwg / NXCD, r = nwg % NXCD, xcd = wgid % NXCD, off = wgid / NXCD; wgid = (xcd < r ? xcd * (q + 1) : r * (q + 1) + (xcd - r) * q) + off; }
        const int nig = WGM * nN, gid = wgid / nig, fm = gid * WGM, gsz = (nM - fm) < WGM ? (nM - fm) : WGM;
        u.pm = fm + ((wgid % nig) % gsz); u.pn = (wgid % nig) / gsz; return true;
    }
};

template <class Epi>
__device__ __forceinline__ void gemm_phase(LAS unsigned char* lds, const Gemm g, const StaticOrder& S, const Epi& E) {
    const int tid = ltid(), wid = __builtin_amdgcn_readfirstlane(tid >> 6), lane = tid & 63, wr = wid >> 2, wc = wid & 3, fr = lane & 15, fq = lane >> 4;
    const int K = g.K, nt = K / BK;
    unsigned voffA[2], voffB[2];
#pragma unroll
    for (int i = 0; i < 2; ++i) { int R, C; stage_rc(tid * 16 + i * 8192, R, C); const int Rb = Epi::PERM ? ((R & ~31) + perm32(R & 31)) : R;
        voffA[i] = (unsigned)(R * K + C) * 2u; voffB[i] = (unsigned)(Rb * K + C) * 2u; }
    const size_t kstep = (size_t)(BK * 2);
    const size_t hstep = (size_t)HALF * K * 2;
    const size_t tstep = 2 * hstep;
    const unsigned ldsw = (unsigned)wid * 1024u;
    const int aoff = lds_byte(wr * 64 + fr, fq * 8), boff = lds_byte(wc * 32 + fr, fq * 8);
#define PG8_SA(b, h) (((b) * 2 + (h)) * HTB)
#define PG8_SB(b, h) ((4 + (b) * 2 + (h)) * HTB)
#define PG8_STAGE(bufoff, gbase, voff) do { _Pragma("unroll") for (int _i = 0; _i < 2; ++_i) \
        __builtin_amdgcn_global_load_lds((const unsigned*)((const char*)(gbase) + (voff)[_i]), (LAS unsigned*)(lds + (bufoff) + ldsw + _i * 8192), 16, 0, 0); } while (0)
#define PG8_LDA(dst, b, h) do { _Pragma("unroll") for (int m = 0; m < 4; ++m) _Pragma("unroll") for (int k = 0; k < 2; ++k) dst[m][k] = *(const LAS bf16x8*)(lds + PG8_SA(b, h) + aoff + m * 2048 + k * 1024); } while (0)
#define PG8_LDB(dst, b, h) do { _Pragma("unroll") for (int n = 0; n < 2; ++n) _Pragma("unroll") for (int k = 0; k < 2; ++k) dst[n][k] = *(const LAS bf16x8*)(lds + PG8_SB(b, h) + boff + n * 2048 + k * 1024); } while (0)
#define PG8_MMA(ai, bj, At, Bt) do { __builtin_amdgcn_s_setprio(1); _Pragma("unroll") for (int m = 0; m < 4; ++m) _Pragma("unroll") for (int n = 0; n < 2; ++n) _Pragma("unroll") for (int k = 0; k < 2; ++k) \
        acc[ai][bj][m][n] = __builtin_amdgcn_mfma_f32_16x16x32_bf16(Bt[n][k], At[m][k], acc[ai][bj][m][n], 0, 0, 0); __builtin_amdgcn_s_setprio(0); } while (0)
#define PG8_WAIT_V(n) asm volatile("s_waitcnt vmcnt(" #n ")" ::: "memory")
#define PG8_WAIT_L(n) asm volatile("s_waitcnt lgkmcnt(" #n ")" ::: "memory")
#define PG8_BAR __builtin_amdgcn_s_barrier()
#define PG8_SCHED __builtin_amdgcn_sched_barrier(0)
    Unit cur, nxt; int ui = 0;
    if (!S.next(0, cur)) return;
    f32x4 acc[2][2][4][2];
#pragma unroll
    for (int a = 0; a < 2; ++a)
#pragma unroll
        for (int b = 0; b < 2; ++b)
#pragma unroll
            for (int m = 0; m < 4; ++m)
#pragma unroll
                for (int n = 0; n < 2; ++n) acc[a][b][m][n] = (f32x4){0.f, 0.f, 0.f, 0.f};
    bf16x8 At[4][2], B0[2][2], B1[2][2];
    const char* cA = (const char*)g.A + (size_t)cur.pm * tstep; const char* cB = (const char*)g.Bt + (size_t)cur.pn * tstep;
    PG8_STAGE(PG8_SB(0, 0), cB, voffB); PG8_STAGE(PG8_SA(0, 0), cA, voffA); PG8_STAGE(PG8_SB(0, 1), cB + hstep, voffB); PG8_STAGE(PG8_SA(0, 1), cA + hstep, voffA);
    if (wr == 1) PG8_BAR;
    PG8_WAIT_V(4); PG8_BAR;
    PG8_STAGE(PG8_SB(1, 0), cB + kstep, voffB); PG8_STAGE(PG8_SA(1, 0), cA + kstep, voffA); PG8_STAGE(PG8_SB(1, 1), cB + hstep + kstep, voffB);
    PG8_WAIT_V(6); PG8_BAR;
    for (;;) {
        const bool has_next = S.next(ui + 1, nxt);
        const char* nA = has_next ? (const char*)g.A + (size_t)nxt.pm * tstep : cA; const char* nB = has_next ? (const char*)g.Bt + (size_t)nxt.pn * tstep : cB;
        for (int t = 0; t < nt; t += 2) {
            const bool last = (t == nt - 2);
            const char* a1 = cA + (size_t)(t + 1) * kstep;
            const char* a2 = last ? nA : cA + (size_t)(t + 2) * kstep; const char* b2 = last ? nB : cB + (size_t)(t + 2) * kstep;
            const char* a3 = a2 + kstep; const char* b3 = b2 + kstep;
            PG8_LDB(B0, 0, 0); PG8_SCHED; PG8_LDA(At, 0, 0); PG8_STAGE(PG8_SA(1, 1), a1 + hstep, voffA);
            PG8_WAIT_L(8); PG8_BAR; PG8_WAIT_L(0); PG8_MMA(0, 0, At, B0); PG8_BAR; PG8_SCHED;
            PG8_LDB(B1, 0, 1); PG8_STAGE(PG8_SB(0, 0), b2, voffB);
            PG8_BAR; PG8_WAIT_L(0); PG8_MMA(0, 1, At, B1); PG8_BAR;
            PG8_LDA(At, 0, 1); PG8_STAGE(PG8_SA(0, 0), a2, voffA);
            PG8_BAR; PG8_WAIT_L(0); PG8_MMA(1, 0, At, B0); PG8_BAR; PG8_SCHED;
            PG8_STAGE(PG8_SB(0, 1), b2 + hstep, voffB);
            PG8_WAIT_V(6); PG8_BAR; PG8_MMA(1, 1, At, B1); PG8_BAR;
            PG8_LDB(B0, 1, 0); PG8_SCHED; PG8_LDA(At, 1, 0); PG8_STAGE(PG8_SA(0, 1), a2 + hstep, voffA);
            PG8_WAIT_L(8); PG8_BAR; PG8_WAIT_L(0); PG8_MMA(0, 0, At, B0); PG8_BAR; PG8_SCHED;
            PG8_LDB(B1, 1, 1); PG8_STAGE(PG8_SB(1, 0), b3, voffB);
            PG8_BAR; PG8_WAIT_L(0); PG8_MMA(0, 1, At, B1); PG8_BAR;
            PG8_LDA(At, 1, 1); PG8_STAGE(PG8_SA(1, 0), a3, voffA);
            PG8_BAR; PG8_WAIT_L(0); PG8_MMA(1, 0, At, B0); PG8_BAR; PG8_SCHED;
            PG8_STAGE(PG8_SB(1, 1), b3 + hstep, voffB);
            PG8_WAIT_V(6); PG8_BAR; PG8_MMA(1, 1, At, B1); PG8_BAR;
        }
        E(acc, cur, wr, wc, fr, fq);
        if (!has_next) break;
#pragma unroll
        for (int a = 0; a < 2; ++a)
#pragma unroll
            for (int b = 0; b < 2; ++b)
#pragma unroll
                for (int m = 0; m < 4; ++m)
#pragma unroll
                    for (int n = 0; n < 2; ++n) acc[a][b][m][n] = (f32x4){0.f, 0.f, 0.f, 0.f};
        cur = nxt; cA = nA; cB = nB; ++ui;
    }
    PG8_WAIT_V(0);
    if (wr == 0) PG8_BAR;
    PG8_BAR;
#undef PG8_SA
#undef PG8_SB
#undef PG8_STAGE
#undef PG8_LDA
#undef PG8_LDB
#undef PG8_MMA
#undef PG8_WAIT_V
#undef PG8_WAIT_L
#undef PG8_BAR
#undef PG8_SCHED
}
}
using pg8::Unit;

struct EpiF32 {
    static constexpr bool PERM = false;
    float* C; int ldc;
    __device__ __forceinline__ void operator()(const f32x4 (&acc)[2][2][4][2], const Unit& u, int wr, int wc, int fr, int fq) const {
        const int row0 = u.pm * 256 + wr * 64 + fr, col0 = u.pn * 256 + wc * 32 + 4 * fq;
#pragma unroll
        for (int ai = 0; ai < 2; ++ai)
#pragma unroll
            for (int m = 0; m < 4; ++m) { float* rowp = C + (size_t)(row0 + ai * 128 + m * 16) * ldc + col0;
#pragma unroll
                for (int bj = 0; bj < 2; ++bj)
#pragma unroll
                    for (int n = 0; n < 2; ++n) *(f32x4*)(rowp + bj * 128 + n * 16) = acc[ai][bj][m][n]; }
    }
};
struct EpiF16 {
    static constexpr bool PERM = true;
    f16* O; int ldc;
    __device__ __forceinline__ void operator()(const f32x4 (&acc)[2][2][4][2], const Unit& u, int wr, int wc, int fr, int fq) const {
        const int row0 = u.pm * 256 + wr * 64 + fr, col0 = u.pn * 256 + wc * 32 + 8 * fq;
#pragma unroll
        for (int ai = 0; ai < 2; ++ai)
#pragma unroll
            for (int m = 0; m < 4; ++m) { f16* rowp = O + (size_t)(row0 + ai * 128 + m * 16) * ldc + col0;
#pragma unroll
                for (int bj = 0; bj < 2; ++bj) { f16x8 v;
#pragma unroll
                    for (int i = 0; i < 4; ++i) { v[i] = (f16)acc[ai][bj][m][0][i]; v[4 + i] = (f16)acc[ai][bj][m][1][i]; }
                    *(f16x8*)(rowp + bj * 128) = v; } }
    }
};
struct EpiWAG {
    static constexpr bool PERM = true;
    f16* O; const float* w0; const float* a0;
    __device__ __forceinline__ void operator()(const f32x4 (&acc)[2][2][4][2], const Unit& u, int wr, int wc, int fr, int fq) const {
        const int type = u.pn >> 2;
        const int row0 = u.pm * 256 + wr * 64 + fr, col0 = u.pn * 256 + wc * 32 + 8 * fq, cl0 = (u.pn & 3) * 256 + wc * 32 + 8 * fq;
        f32x4 bv[2][2];
#pragma unroll
        for (int bj = 0; bj < 2; ++bj)
#pragma unroll
            for (int n = 0; n < 2; ++n) {
                if (type < 2) bv[bj][n] = *(const f32x4*)(w0 + type * 1024 + cl0 + bj * 128 + 4 * n);
                else if (type == 2) bv[bj][n] = *(const f32x4*)(a0 + cl0 + bj * 128 + 4 * n);
                else bv[bj][n] = (f32x4){0.f, 0.f, 0.f, 0.f};
            }
#pragma unroll
        for (int ai = 0; ai < 2; ++ai)
#pragma unroll
            for (int m = 0; m < 4; ++m) { f16* rowp = O + (size_t)(row0 + ai * 128 + m * 16) * 4096 + col0;
#pragma unroll
                for (int bj = 0; bj < 2; ++bj) { f16x8 v;
#pragma unroll
                    for (int n = 0; n < 2; ++n)
#pragma unroll
                        for (int i = 0; i < 4; ++i) { float xv = acc[ai][bj][m][n][i] + bv[bj][n][i]; float r;
                            if (type < 2) { const float sg = sigmoidf_(xv); r = -expm1f(-0.606531f * sg); }
                            else if (type == 2) r = sigmoidf_(xv);
                            else r = xv;
                            v[4 * n + i] = (f16)r; }
                    *(f16x8*)(rowp + bj * 128) = v; } }
    }
};
struct EpiSwiGLU {
    static constexpr bool PERM = true;
    u16* O;
    __device__ __forceinline__ void operator()(const f32x4 (&acc)[2][2][4][2], const Unit& u, int wr, int wc, int fr, int fq) const {
        const int row0 = u.pm * 256 + wr * 64 + fr, col0 = u.pn * 128 + wc * 32 + 8 * fq;
#pragma unroll
        for (int ai = 0; ai < 2; ++ai)
#pragma unroll
            for (int m = 0; m < 4; ++m) { float hv[8];
#pragma unroll
                for (int n = 0; n < 2; ++n)
#pragma unroll
                    for (int i = 0; i < 4; ++i) { const float gt = acc[ai][0][m][n][i], up = acc[ai][1][m][n][i]; hv[4 * n + i] = gt * sigmoidf_(gt) * up; }
                u32x4 o; o[0] = cvt_pk_bf16(hv[0], hv[1]); o[1] = cvt_pk_bf16(hv[2], hv[3]); o[2] = cvt_pk_bf16(hv[4], hv[5]); o[3] = cvt_pk_bf16(hv[6], hv[7]);
                *(u32x4*)(O + (size_t)(row0 + ai * 128 + m * 16) * 5632 + col0) = o; }
    }
};
struct EpiQKV {
    static constexpr bool PERM = false;
    u16* QK; u16* VT; const float* cs; const float* sn;
    __device__ __forceinline__ void operator()(const f32x4 (&acc)[2][2][4][2], const Unit& u, int wr, int wc, int fr, int fq) const {
        const int row0 = u.pm * 256 + wr * 64 + fr;
        if (u.pn < 16) {
            const float qs = u.pn < 8 ? (0.125f * 1.44269504089f) : 1.0f;
            const int j0 = 16 * (wc & 1) + 4 * fq;
#pragma unroll
            for (int ai = 0; ai < 2; ++ai)
#pragma unroll
                for (int m = 0; m < 4; ++m) { const int row = row0 + ai * 128 + m * 16, t = row & 4095;
                    const f32x4 c4 = *(const f32x4*)(cs + t * 32 + j0), s4 = *(const f32x4*)(sn + t * 32 + j0);
#pragma unroll
                    for (int bj = 0; bj < 2; ++bj) { const int hh = 2 * bj + (wc >> 1);
                        const f32x4 x1 = acc[ai][bj][m][0], x2 = acc[ai][bj][m][1]; float o1[4], o2[4];
#pragma unroll
                        for (int i = 0; i < 4; ++i) { o1[i] = (x1[i] * c4[i] - x2[i] * s4[i]) * qs; o2[i] = (x2[i] * c4[i] + x1[i] * s4[i]) * qs; }
                        u16* dst = QK + (size_t)row * 4096 + u.pn * 256 + 64 * hh + j0;
                        u32x2 a, b; a[0] = cvt_pk_bf16(o1[0], o1[1]); a[1] = cvt_pk_bf16(o1[2], o1[3]); b[0] = cvt_pk_bf16(o2[0], o2[1]); b[1] = cvt_pk_bf16(o2[2], o2[3]);
                        *(u32x2*)dst = a; *(u32x2*)(dst + 32) = b; } }
        } else {
            const int cv0 = (u.pn - 16) * 256 + wc * 32 + 4 * fq;
#pragma unroll
            for (int ai = 0; ai < 2; ++ai)
#pragma unroll
                for (int m = 0; m < 4; ++m) { const int row = row0 + ai * 128 + m * 16, t = row & 4095, b = row >> 12;
#pragma unroll
                    for (int bj = 0; bj < 2; ++bj)
#pragma unroll
                        for (int n = 0; n < 2; ++n)
#pragma unroll
                            for (int i = 0; i < 4; ++i) { const int cv = cv0 + bj * 128 + n * 16 + i;
                                VT[((size_t)(b * 2048 + cv)) * 4096 + t] = f2bf(acc[ai][bj][m][n][i]); } }
        }
    }
};

template <class Epi>
__device__ __forceinline__ void run_gemm(unsigned char* lds, const u16* A, const u16* Bt, int N, int K, const Epi& E) {
    pg8::StaticOrder S; S.init(16384, N, (int)gridDim.x, (int)blockIdx.x);
    pg8::Gemm g; g.A = A; g.Bt = Bt; g.M = 16384; g.N = N; g.K = K;
    pg8::gemm_phase<Epi>((LAS unsigned char*)lds, g, S, E);
}

__device__ __forceinline__ int sigma_map(int mode, int n, int nsrc) {
    if (mode == 0) return n < nsrc ? n : -1;
    if (mode == 1) { const int pn = n >> 8, r = n & 255; return r < 128 ? pn * 128 + r : 5632 + pn * 128 + (r - 128); }
    if (n >= 4096) return n;
    const int pn = n >> 8, r = n & 255, w = r >> 5, nn = (r >> 4) & 1, l = r & 15;
    return pn * 256 + 64 * (w >> 1) + 32 * nn + 16 * (w & 1) + l;
}
__device__ __forceinline__ void convert_weight(const float* __restrict__ W, u16* __restrict__ Bt, int K, int nsrc, int np, int mode, float* tl) {
    const int tid = ltid(); const int nkt = K >> 7, ntile = nkt * (np >> 6);
    for (int tile = blockIdx.x; tile < ntile; tile += gridDim.x) {
        const int ktile = tile % nkt, ntl = tile / nkt; const int k0 = ktile << 7, n0 = ntl << 6;
        const int nn = tid & 63, kk0 = tid >> 6;
        const int src = sigma_map(mode, n0 + nn, nsrc);
        float v[16];
#pragma unroll
        for (int i = 0; i < 16; ++i) v[i] = src >= 0 ? __builtin_nontemporal_load(W + (size_t)(k0 + kk0 + 8 * i) * nsrc + src) : 0.f;
#pragma unroll
        for (int i = 0; i < 16; ++i) tl[(kk0 + 8 * i) * 65 + nn] = v[i];
        __syncthreads();
        const int n = tid >> 3, ks = tid & 7;
        u32x4 o0, o1;
#pragma unroll
        for (int j = 0; j < 4; ++j) { o0[j] = cvt_pk_bf16(tl[(16 * ks + 2 * j) * 65 + n], tl[(16 * ks + 2 * j + 1) * 65 + n]); o1[j] = cvt_pk_bf16(tl[(16 * ks + 8 + 2 * j) * 65 + n], tl[(16 * ks + 9 + 2 * j) * 65 + n]); }
        u16* dst = Bt + (size_t)(n0 + n) * K + k0 + 16 * ks;
        *(u32x4*)dst = o0; *(u32x4*)(dst + 8) = o1;
        __syncthreads();
    }
}
__device__ __forceinline__ void phase0(const Params& p, unsigned char* lds) {
    float* tl = (float*)lds;
    unsigned char* ws = p.ws;
    const int tid = ltid(); const int gtid = blockIdx.x * 512 + tid, nth = gridDim.x * 512;
    {
        float* sc = (float*)lds;
        float* part = (float*)(ws + OFF_PART);
        for (int it = blockIdx.x; it < 768; it += gridDim.x) {
            const int kc = it & 15, nc = (it >> 4) % 12, s = it / 192; const int k0 = kc * 128;
            { const int b = tid >> 7, kk = tid & 127; const float cv = p.c[b * 2048 + k0 + kk]; sc[tid] = cv * sigmoidf_(cv); }
            __syncthreads();
            const int n = nc * 512 + tid; const float* W = p.ada_w + ((size_t)s * 2048 + k0) * 6144 + n;
            float a0 = 0.f, a1 = 0.f, a2 = 0.f, a3 = 0.f;
#pragma unroll 16
            for (int kk = 0; kk < 128; ++kk) { const float w = __builtin_nontemporal_load(W + (size_t)kk * 6144); a0 += sc[kk] * w; a1 += sc[128 + kk] * w; a2 += sc[256 + kk] * w; a3 += sc[384 + kk] * w; }
            float* po = part + (size_t)kc * 98304 + s * 24576 + n;
            po[0] = a0; po[6144] = a1; po[12288] = a2; po[18432] = a3;
            __syncthreads();
        }
    }
    convert_weight(p.ab_w_in, (u16*)(ws + OFF_WB_ABIN), 2048, 6608, 6656, 0, tl);
    convert_weight(p.ab_w_out, (u16*)(ws + OFF_WB_ABOUT), 2048, 2048, 2048, 0, tl);
    {
        u16* Bt = (u16*)(ws + OFF_WB_LORA);
        for (int idx = gtid; idx < 4096 * 512; idx += nth) { const int n = idx >> 9, k = idx & 511; float v = 0.f;
            if (n < 2048) { if (k < 96) v = p.rwkv_w_up[((size_t)(n >> 10) * 96 + k) * 1024 + (n & 1023)]; }
            else if (n < 3072) { if (k >= 96 && k < 192) v = p.rwkv_a_up[(size_t)(k - 96) * 1024 + (n - 2048)]; }
            else { if (k >= 192 && k < 448) v = p.rwkv_g_up[(size_t)(k - 192) * 1024 + (n - 3072)]; }
            Bt[idx] = f2bf(v); }
    }
    {
        float* cs = (float*)(ws + OFF_ROPE); float* sn = cs + 4096 * 32;
        for (int idx = gtid; idx < 4096 * 32; idx += nth) { const int t = idx >> 5, i = idx & 31;
            const float inv = powf(10000.0f, -(float)(2 * i) / 64.0f); const float ang = (float)t * inv;
            const double rev = (double)ang * 0.15915494309189535; const float fr = (float)(rev - rint(rev));
            cs[idx] = __builtin_amdgcn_cosf(fr); sn[idx] = __builtin_amdgcn_sinf(fr); }
    }
}
__device__ __forceinline__ void phase_mods(const Params& p) {
    const float* part = (const float*)(p.ws + OFF_PART); float* mods = (float*)(p.ws + OFF_MODS);
    for (int idx = blockIdx.x * 512 + ltid(); idx < 98304; idx += gridDim.x * 512) {
        const int s = idx / 24576, n = idx % 6144; float a = p.ada_b[s * 6144 + n];
#pragma unroll
        for (int kc = 0; kc < 16; ++kc) a += part[(size_t)kc * 98304 + idx];
        mods[idx] = a; }
}
__device__ __forceinline__ void phase_modulate(const Params& p) {
    const float* mods = (const float*)(p.ws + OFF_MODS); u16* H = (u16*)(p.ws + OFF_H);
    for (int idx = blockIdx.x * 512 + ltid(); idx < 16384 * 512; idx += gridDim.x * 512) {
        const int m = idx >> 9, c = (idx & 511) * 4, b = m >> 12;
        const f32x4 xv = __builtin_nontemporal_load((const f32x4*)(p.x + (size_t)m * 2048 + c)), sh = *(const f32x4*)(mods + b * 6144 + c), scl = *(const f32x4*)(mods + b * 6144 + 2048 + c);
        u32x2 o; o[0] = cvt_pk_bf16(xv[0] * (1.f + scl[0]) + sh[0], xv[1] * (1.f + scl[1]) + sh[1]); o[1] = cvt_pk_bf16(xv[2] * (1.f + scl[2]) + sh[2], xv[3] * (1.f + scl[3]) + sh[3]);
        *(u32x2*)(H + (size_t)m * 2048 + c) = o; }
}

__device__ __forceinline__ void phase_prep(const Params& p, unsigned char* lds) {
    const f16* Z = (const f16*)(p.ws + OFF_Z); u16* L = (u16*)(p.ws + OFF_L);
    const int tid = ltid();
    for (int idx = blockIdx.x * 512 + tid; idx < 16384 * 64; idx += gridDim.x * 512) {
        const int m = idx >> 6, grp = idx & 63, t = m & 4095; u32x4 o = (u32x4){0u, 0u, 0u, 0u};
        if (grp < 56) {
            const int zc = 3072 + 8 * grp; const f16* zp = Z + (size_t)m * ZLD + zc;
            const f16x8 z1 = *(const f16x8*)zp; f16x8 z0, z2;
            if (t > 0) z0 = *(const f16x8*)(zp - ZLD); else { for (int j = 0; j < 8; ++j) z0[j] = (f16)0.f; }
            if (t < 4095) z2 = *(const f16x8*)(zp + ZLD); else { for (int j = 0; j < 8; ++j) z2[j] = (f16)0.f; }
            float v[8];
#pragma unroll
            for (int j = 0; j < 8; ++j) { const float a = (float)z1[j]; const float zs = a + (0.5f * ((float)z0[j] + (float)z2[j]) - a) * p.rwkv_mu[zc + j];
                v[j] = grp < 12 ? tanhf(zs) : (grp < 24 ? zs : sigmoidf_(zs)); }
            o[0] = cvt_pk_bf16(v[0], v[1]); o[1] = cvt_pk_bf16(v[2], v[3]); o[2] = cvt_pk_bf16(v[4], v[5]); o[3] = cvt_pk_bf16(v[6], v[7]);
        }
        *(u32x4*)(L + (size_t)m * 512 + 8 * grp) = o;
    }
    float* sg = (float*)lds;
    u16* QB = (u16*)(p.ws + OFF_H); u16* KB = QB + (size_t)2 * 16384 * 512; float* DEC = (float*)(p.ws + OFF_PART);
    for (int pass = 0; pass < 2; ++pass) {
        const int cmb = tid + 512 * pass, dir = cmb >> 9, d = cmb & 511;
        float gu[16];
#pragma unroll
        for (int r = 0; r < 16; ++r) gu[r] = p.gla_gate_up[((size_t)dir * 16 + r) * 512 + d];
        const float gb = p.gla_gate_b[dir * 512 + d];
        for (int tile = blockIdx.x; tile < 256; tile += gridDim.x) {
            const int m0 = tile * 64;
            { const int tok = tid >> 3, r2 = (tid & 7) * 2; const f16x2 gv = *(const f16x2*)(Z + (size_t)(m0 + tok) * ZLD + 5568 + r2); sg[tok * 16 + r2] = (float)gv[0]; sg[tok * 16 + r2 + 1] = (float)gv[1]; }
            __syncthreads();
            float bsum = 0.f;
            for (int sidx = 0; sidx < 64; ++sidx) { const int tok = dir ? 63 - sidx : sidx; float uu = gb;
#pragma unroll
                for (int r = 0; r < 16; ++r) uu += sg[tok * 16 + r] * gu[r];
                const float ls = fminf(uu, 0.f) - __logf(1.0f + __expf(-fabsf(uu)));
                bsum += ls * 0.0625f;
                const f16* zp = Z + (size_t)(m0 + tok) * ZLD;
                const float qv = (float)zp[3520 + d], kv = (float)zp[4032 + d];
                const size_t o = ((size_t)dir * 16384 + m0 + tok) * 512 + d;
                QB[o] = f2bf(qv * 0.08838834764831845f * __expf(bsum)); KB[o] = f2bf(kv * __expf(-bsum)); }
            DEC[((size_t)dir * 256 + tile) * 512 + d] = __expf(bsum);
            __syncthreads();
        }
    }
}

struct ConvDesc { const float* W; u16* Bt; int K, nsrc, mode, rel; };
__device__ __forceinline__ ConvDesc conv_decode(const Params& p, int pid) {
    ConvDesc d; unsigned char* ws = p.ws;
    if (pid < 22528)      { d.W = p.ffn_w_in;  d.Bt = (u16*)(ws + OFF_WB_FFNIN0);  d.K = 2048; d.nsrc = 11264; d.mode = 1; d.rel = pid; }
    else if (pid < 33792) { d.W = p.ffn_w_out; d.Bt = (u16*)(ws + OFF_WB_FFNOUT0); d.K = 5632; d.nsrc = 2048;  d.mode = 0; d.rel = pid - 22528; }
    else if (pid < 46080) { d.W = p.diff_w_in; d.Bt = (u16*)(ws + OFF_WB_DIN);     d.K = 2048; d.nsrc = 6144;  d.mode = 2; d.rel = pid - 33792; }
    else if (pid < 50176) { d.W = p.diff_w_out; d.Bt = (u16*)(ws + OFF_WB_DOUT);   d.K = 2048; d.nsrc = 2048;  d.mode = 0; d.rel = pid - 46080; }
    else if (pid < 72704) { d.W = p.ffn_w_in + (size_t)2048 * 11264;  d.Bt = (u16*)(ws + OFF_WB_FFNIN1);  d.K = 2048; d.nsrc = 11264; d.mode = 1; d.rel = pid - 50176; }
    else                  { d.W = p.ffn_w_out + (size_t)5632 * 2048;  d.Bt = (u16*)(ws + OFF_WB_FFNOUT1); d.K = 5632; d.nsrc = 2048;  d.mode = 0; d.rel = pid - 72704; }
    return d;
}
constexpr int CONV_PIECES = 83968;
__device__ __forceinline__ void conv_load(const Params& p, int pid, int lane, float (&cv)[16], int& nt, int& kp, u16*& dst) {
    const ConvDesc d = conv_decode(p, pid);
    if (d.rel == 0) { nt = 0; kp = 0; }
    const int src = sigma_map(d.mode, nt * 64 + lane, d.nsrc);
    const float* wp = d.W + (size_t)(16 * kp) * d.nsrc + src;
#pragma unroll
    for (int j = 0; j < 16; ++j) cv[j] = __builtin_nontemporal_load(wp + (size_t)j * d.nsrc);
    dst = d.Bt + (size_t)(nt * 64 + lane) * d.K + 16 * kp;
    ++kp; if (kp == (d.K >> 4)) { kp = 0; ++nt; }
}
__device__ __forceinline__ void conv_store(u16* dst, const float (&cv)[16]) {
    u32x4 o0, o1;
#pragma unroll
    for (int j = 0; j < 4; ++j) { o0[j] = cvt_pk_bf16(cv[2 * j], cv[2 * j + 1]); o1[j] = cvt_pk_bf16(cv[8 + 2 * j], cv[9 + 2 * j]); }
    *(u32x4*)dst = o0; *(u32x4*)(dst + 8) = o1;
}
#define SC_BAR() do { asm volatile("s_waitcnt lgkmcnt(0)" ::: "memory"); __builtin_amdgcn_s_barrier(); asm volatile("" ::: "memory"); } while (0)
__device__ __forceinline__ float dpp_sum8(float x) {
    x += __builtin_bit_cast(float, __builtin_amdgcn_update_dpp(0, __builtin_bit_cast(int, x), 0xB1, 0xF, 0xF, true));
    x += __builtin_bit_cast(float, __builtin_amdgcn_update_dpp(0, __builtin_bit_cast(int, x), 0x4E, 0xF, 0xF, true));
    x += __builtin_bit_cast(float, __builtin_amdgcn_update_dpp(0, __builtin_bit_cast(int, x), 0x141, 0xF, 0xF, true));
    return x;
}
__device__ __forceinline__ float afma(float a, float b, float c) { float d; asm("v_fma_f32 %0, %1, %2, %3" : "=v"(d) : "v"(a), "v"(b), "v"(c)); return d; }
__device__ __forceinline__ float amul(float a, float b) { float d; asm("v_mul_f32 %0, %1, %2" : "=v"(d) : "v"(a), "v"(b)); return d; }
struct RwRaw { f16x8 r0, r1, r2, k0, k1, k2, v0, v1, v2, a, w; };
__device__ __forceinline__ int launder_v(int x) { asm volatile("" : "+v"(x)); return x; }
__device__ __forceinline__ void phase_scans(const Params& p, unsigned char* lds) {
    const f16* Z = (const f16*)(p.ws + OFF_Z);
    const int tid = ltid(); const int wv = __builtin_amdgcn_readfirstlane(tid >> 6);
    float* sRW = (float*)lds;
    unsigned char* sGLA = lds + 54272;
    for (int item = blockIdx.x; item < 256; item += gridDim.x) {
        if (wv < 4) {
            const int rh = item & 1;
            const int ct = launder_v(tid); const int rowl = ct >> 3, ksl = ct & 7;
            __builtin_amdgcn_s_setprio(3);
            float S[8];
#pragma unroll
            for (int j = 0; j < 8; ++j) S[j] = 0.f;
            SC_BAR();
            for (int ci = 0; ci < 256; ++ci) {
                const float* bufp = sRW + (ci & 1) * 6656;
                const float* sO = bufp + 4 * ksl; const float* sV = bufp + 5120 + 32 * rh + rowl;
                float* ydst = (ksl == 0) ? ((float*)bufp + 6144 + rowl) : (sRW + 13312 + ct);
                const int ystep = (ksl == 0) ? 32 : 0;
#define RW_OPS(s_, r_, w_, k_, kk_, na_, v_) do { const float* q_ = sO + (s_) * 64; \
                r_[0] = *(const f32x4*)q_; r_[1] = *(const f32x4*)(q_ + 32); w_[0] = *(const f32x4*)(q_ + 1024); w_[1] = *(const f32x4*)(q_ + 1056); k_[0] = *(const f32x4*)(q_ + 2048); k_[1] = *(const f32x4*)(q_ + 2080); \
                kk_[0] = *(const f32x4*)(q_ + 3072); kk_[1] = *(const f32x4*)(q_ + 3104); na_[0] = *(const f32x4*)(q_ + 4096); na_[1] = *(const f32x4*)(q_ + 4128); v_ = sV[(s_) * 64]; } while (0)
                f32x4 r4[2], w4[2], k4[2], kk4[2], na4[2]; float v1;
                RW_OPS(0, r4, w4, k4, kk4, na4, v1);
#pragma unroll 2
                for (int s = 0; s < 16; ++s) {
                    const int sn = (s + 1) & 15;
                    f32x4 r4n[2], w4n[2], k4n[2], kk4n[2], na4n[2]; float v1n;
                    RW_OPS(sn, r4n, w4n, k4n, kk4n, na4n, v1n);
                    float d0 = amul(S[0], kk4[0][0]), d1 = amul(S[4], kk4[1][0]);
#pragma unroll
                    for (int j = 1; j < 4; ++j) { d0 = afma(S[j], kk4[0][j], d0); d1 = afma(S[4 + j], kk4[1][j], d1); }
                    const float d = dpp_sum8(d0 + d1);
#pragma unroll
                    for (int j = 0; j < 4; ++j) {
                        S[j] = afma(v1, k4[0][j], afma(S[j], w4[0][j], amul(d, na4[0][j])));
                        S[4 + j] = afma(v1, k4[1][j], afma(S[4 + j], w4[1][j], amul(d, na4[1][j]))); }
                    float y0 = amul(S[0], r4[0][0]), y1 = amul(S[4], r4[1][0]);
#pragma unroll
                    for (int j = 1; j < 4; ++j) { y0 = afma(S[j], r4[0][j], y0); y1 = afma(S[4 + j], r4[1][j], y1); }
                    const float y = dpp_sum8(y0 + y1);
                    ydst[s * ystep] = y;
#pragma unroll
                    for (int q = 0; q < 2; ++q) { r4[q] = r4n[q]; w4[q] = w4n[q]; k4[q] = k4n[q]; kk4[q] = kk4n[q]; na4[q] = na4n[q]; }
                    v1 = v1n;
                }
#undef RW_OPS
                SC_BAR();
            }
            __builtin_amdgcn_s_setprio(0);
        } else if (wv < 6) {
            const int ptid = launder_v(tid) & 127;
            const f16* WAG = (const f16*)(p.ws + OFF_WAG); f16* YS = (f16*)(p.ws + OFF_YS);
            const int rh = item & 1, hd = item >> 1, h = hd & 15, b = (hd >> 4) & 3, dir = hd >> 6;
            const int tp = ptid >> 3, cg8 = ptid & 7, c0 = 64 * h + 8 * cg8;
            float mu_r[8], mu_k[8], mu_v[8], kkw[8], kaw[8];
#pragma unroll
            for (int j = 0; j < 8; ++j) { mu_r[j] = p.rwkv_mu[c0 + j]; mu_k[j] = p.rwkv_mu[1024 + c0 + j]; mu_v[j] = p.rwkv_mu[2048 + c0 + j]; kkw[j] = p.rwkv_k_k[c0 + j]; kaw[j] = p.rwkv_k_a[c0 + j]; }
            const f16x8 zero8 = {(f16)0.f, (f16)0.f, (f16)0.f, (f16)0.f, (f16)0.f, (f16)0.f, (f16)0.f, (f16)0.f};
            RwRaw A, B;
#define RW_LOAD(X, ci) do { const int n_ = (ci) * 16 + tp; const int t_ = dir ? 4095 - n_ : n_; const size_t m_ = (size_t)b * 4096 + t_; const f16* zp_ = Z + m_ * ZLD + c0; \
            X.r1 = *(const f16x8*)zp_; X.k1 = *(const f16x8*)(zp_ + 1024); X.v1 = *(const f16x8*)(zp_ + 2048); \
            if (t_ > 0) { X.r0 = *(const f16x8*)(zp_ - ZLD); X.k0 = *(const f16x8*)(zp_ - ZLD + 1024); X.v0 = *(const f16x8*)(zp_ - ZLD + 2048); } else { X.r0 = zero8; X.k0 = zero8; X.v0 = zero8; } \
            if (t_ < 4095) { X.r2 = *(const f16x8*)(zp_ + ZLD); X.k2 = *(const f16x8*)(zp_ + ZLD + 1024); X.v2 = *(const f16x8*)(zp_ + ZLD + 2048); } else { X.r2 = zero8; X.k2 = zero8; X.v2 = zero8; } \
            X.a = *(const f16x8*)(WAG + m_ * 4096 + 2048 + c0); X.w = *(const f16x8*)(WAG + m_ * 4096 + 1024 * dir + c0); } while (0)
#define RW_PROC(X, bufp) do { float* sR = (bufp); \
            float rr[8], kp[8], vv[8], kkr[8], av[8], wv_[8]; float ss = 0.f; \
            _Pragma("unroll") for (int j = 0; j < 8; ++j) { \
                const float r1 = (float)X.r1[j], k1 = (float)X.k1[j], v1 = (float)X.v1[j]; \
                rr[j] = r1 + (0.5f * ((float)X.r0[j] + (float)X.r2[j]) - r1) * mu_r[j]; \
                const float kx = k1 + (0.5f * ((float)X.k0[j] + (float)X.k2[j]) - k1) * mu_k[j]; \
                vv[j] = v1 + (0.5f * ((float)X.v0[j] + (float)X.v2[j]) - v1) * mu_v[j]; \
                av[j] = (float)X.a[j]; wv_[j] = 1.0f - (float)X.w[j]; \
                kkr[j] = kx * kkw[j]; ss += kkr[j] * kkr[j]; \
                kp[j] = kx * (1.0f + (av[j] - 1.0f) * kaw[j]); } \
            ss = dpp_sum8(ss); \
            const float inv = __builtin_amdgcn_rsqf(fmaxf(ss, 1e-24f)); \
            const int o = tp * 64 + 4 * cg8; f32x4 t0, t1; \
            _Pragma("unroll") for (int j = 0; j < 4; ++j) { t0[j] = rr[j]; t1[j] = rr[4 + j]; } *(f32x4*)(sR + o) = t0; *(f32x4*)(sR + o + 32) = t1; \
            _Pragma("unroll") for (int j = 0; j < 4; ++j) { t0[j] = wv_[j]; t1[j] = wv_[4 + j]; } *(f32x4*)(sR + 1024 + o) = t0; *(f32x4*)(sR + 1024 + o + 32) = t1; \
            _Pragma("unroll") for (int j = 0; j < 4; ++j) { t0[j] = kp[j]; t1[j] = kp[4 + j]; } *(f32x4*)(sR + 2048 + o) = t0; *(f32x4*)(sR + 2048 + o + 32) = t1; \
            _Pragma("unroll") for (int j = 0; j < 4; ++j) { t0[j] = kkr[j] * inv; t1[j] = kkr[4 + j] * inv; } *(f32x4*)(sR + 3072 + o) = t0; *(f32x4*)(sR + 3072 + o + 32) = t1; \
            _Pragma("unroll") for (int j = 0; j < 4; ++j) { t0[j] = -kkr[j] * inv * av[j]; t1[j] = -kkr[4 + j] * inv * av[4 + j]; } *(f32x4*)(sR + 4096 + o) = t0; *(f32x4*)(sR + 4096 + o + 32) = t1; \
            const int ov = tp * 64 + 8 * cg8; \
            _Pragma("unroll") for (int j = 0; j < 4; ++j) { t0[j] = vv[j]; t1[j] = vv[4 + j]; } *(f32x4*)(sR + 5120 + ov) = t0; *(f32x4*)(sR + 5120 + ov + 4) = t1; } while (0)
#define RW_FLUSH(bufp, ci) do { const float* sY = (bufp) + 6144; const int s_ = ptid >> 3, rr4 = (ptid & 7) * 4; const int n_ = (ci) * 16 + s_; const int t_ = dir ? 4095 - n_ : n_; \
            const f32x4 yv = *(const f32x4*)(sY + s_ * 32 + rr4); f16x4 o_; o_[0] = (f16)yv[0]; o_[1] = (f16)yv[1]; o_[2] = (f16)yv[2]; o_[3] = (f16)yv[3]; \
            *(f16x4*)(YS + ((size_t)dir * 16384 + (size_t)b * 4096 + t_) * 1024 + 64 * h + 32 * rh + rr4) = o_; } while (0)
            RW_LOAD(A, 0); RW_PROC(A, sRW); RW_LOAD(B, 1); RW_LOAD(A, 2);
            SC_BAR();
            for (int ci = 0; ci < 256; ci += 2) {
                if (ci >= 1) RW_FLUSH(sRW + 6656, ci - 1);
                RW_PROC(B, sRW + 6656); if (ci + 3 < 256) RW_LOAD(B, ci + 3);
                SC_BAR();
                RW_FLUSH(sRW, ci);
                if (ci + 2 < 256) { RW_PROC(A, sRW); if (ci + 4 < 256) RW_LOAD(A, ci + 4); }
                SC_BAR();
            }
            RW_FLUSH(sRW + 6656, 255);
#undef RW_LOAD
#undef RW_PROC
#undef RW_FLUSH
        } else {
            const int gt0 = launder_v(tid); const int gw = wv - 6, lane = gt0 & 63, fr = lane & 15, g = lane >> 4;
            const u16* QB = (const u16*)(p.ws + OFF_H); const u16* KB = QB + (size_t)2 * 16384 * 512; const float* DEC = (const float*)(p.ws + OFF_PART);
            f16* OS = (f16*)(p.ws + OFF_OS);
            const int vs = item & 7, seq = item >> 3, h = seq & 3, b = (seq >> 2) & 3, dir = seq >> 4;
            u16* sQ = (u16*)sGLA; u16* sK = (u16*)(sGLA + 17408); u16* sKT = (u16*)(sGLA + 34816); u16* sVT = (u16*)(sGLA + 53248); u16* sST = (u16*)(sGLA + 57856); float* sDEC = (float*)(sGLA + 66560);
            f32x4 Sacc[4][2];
#pragma unroll
            for (int a_ = 0; a_ < 4; ++a_)
#pragma unroll
                for (int b_ = 0; b_ < 2; ++b_) Sacc[a_][b_] = (f32x4){0.f, 0.f, 0.f, 0.f};
            u32x4 rq[8], rk[8]; f16x8 rv[2]; float rdec;
            float cv[16];
            const int nworkers = (int)gridDim.x * 2; const int ppw = (CONV_PIECES + nworkers - 1) / nworkers;
            const int cbeg = __builtin_amdgcn_readfirstlane(item == (int)blockIdx.x ? ((int)blockIdx.x * 2 + gw) * ppw : CONV_PIECES);
            const int cend = cbeg + ppw < CONV_PIECES ? cbeg + ppw : CONV_PIECES;
            int cpid = cbeg, cnt_ = 0, ckp_ = 0; u16* cdst = nullptr;
            if (cbeg < cend) { const ConvDesc d0 = conv_decode(p, cbeg); const int kpn0 = d0.K >> 4; cnt_ = d0.rel / kpn0; ckp_ = d0.rel - cnt_ * kpn0; }
#define CONV_STEP() do { if (cpid > cbeg && cpid <= cend) conv_store(cdst, cv); if (cpid < cend) conv_load(p, cpid, lane, cv, cnt_, ckp_, cdst); if (cpid <= cend) ++cpid; } while (0)
#define GL_LOADG(c) do { const int gtid = launder_v(gt0) & 127; _Pragma("unroll") for (int q_ = 0; q_ < 8; ++q_) { const int id_ = gtid + 128 * q_, row_ = id_ >> 4, c16_ = id_ & 15; \
                const int t_ = dir ? 4095 - (64 * (c) + row_) : 64 * (c) + row_; const size_t o_ = ((size_t)dir * 16384 + (size_t)b * 4096 + t_) * 512 + 128 * h + 8 * c16_; \
                rq[q_] = *(const u32x4*)(QB + o_); rk[q_] = *(const u32x4*)(KB + o_); } \
            _Pragma("unroll") for (int q_ = 0; q_ < 2; ++q_) { const int id_ = gtid + 128 * q_, row_ = id_ >> 2, pt_ = id_ & 3; \
                const int t_ = dir ? 4095 - (64 * (c) + row_) : 64 * (c) + row_; rv[q_] = *(const f16x8*)(Z + ((size_t)b * 4096 + t_) * ZLD + 4544 + 256 * h + 32 * vs + 8 * pt_); } \
            rdec = DEC[((size_t)dir * 256 + b * 64 + (dir ? 63 - (c) : (c))) * 512 + 128 * h + gtid]; } while (0)
            GL_LOADG(0);
            for (int i_ = (gt0 & 127); i_ < 2176; i_ += 128) ((unsigned*)sST)[i_] = 0u;
            SC_BAR();
            for (int c = 0; c < 64; ++c) {
                const int gtid = launder_v(gt0) & 127;
                CONV_STEP();
#pragma unroll
                for (int q_ = 0; q_ < 8; ++q_) { const int id_ = gtid + 128 * q_, row_ = id_ >> 4, c16_ = id_ & 15;
                    *(u32x4*)(sQ + row_ * 136 + 8 * c16_) = rq[q_]; *(u32x4*)(sK + row_ * 136 + 8 * c16_) = rk[q_];
#pragma unroll
                    for (int e = 0; e < 4; ++e) { sKT[(8 * c16_ + 2 * e) * 72 + row_] = (u16)(rk[q_][e] & 0xFFFFu); sKT[(8 * c16_ + 2 * e + 1) * 72 + row_] = (u16)(rk[q_][e] >> 16); } }
#pragma unroll
                for (int q_ = 0; q_ < 2; ++q_) { const int id_ = gtid + 128 * q_, row_ = id_ >> 2, pt_ = id_ & 3;
#pragma unroll
                    for (int e = 0; e < 8; ++e) sVT[(8 * pt_ + e) * 72 + row_] = f2bf((float)rv[q_][e]); }
                sDEC[gtid] = rdec;
                SC_BAR();
                if (c + 1 < 64) GL_LOADG(c + 1);
                CONV_STEP();
#define GL_IT(it) do { \
                    bf16x8 qf[4]; \
                    _Pragma("unroll") for (int ds = 0; ds < 4; ++ds) qf[ds] = *(const bf16x8*)(sQ + (16 * (it) + fr) * 136 + 32 * ds + 8 * g); \
                    f32x4 att[4]; \
                    _Pragma("unroll") for (int jt = 0; jt < 4; ++jt) { att[jt] = (f32x4){0.f, 0.f, 0.f, 0.f}; \
                        if (jt <= (it)) { \
                            _Pragma("unroll") for (int ds = 0; ds < 4; ++ds) { const bf16x8 kf = *(const bf16x8*)(sK + (16 * jt + fr) * 136 + 32 * ds + 8 * g); \
                                att[jt] = __builtin_amdgcn_mfma_f32_16x16x32_bf16(kf, qf[ds], att[jt], 0, 0, 0); } \
                            if (jt == (it)) { _Pragma("unroll") for (int r = 0; r < 4; ++r) att[jt][r] = (4 * g + r <= fr) ? att[jt][r] : 0.f; } } } \
                    bf16x8 pb[2]; \
                    _Pragma("unroll") for (int s2 = 0; s2 < 2; ++s2) { u32x4 pk; pk[0] = cvt_pk_bf16(att[2 * s2][0], att[2 * s2][1]); pk[1] = cvt_pk_bf16(att[2 * s2][2], att[2 * s2][3]); \
                        pk[2] = cvt_pk_bf16(att[2 * s2 + 1][0], att[2 * s2 + 1][1]); pk[3] = cvt_pk_bf16(att[2 * s2 + 1][2], att[2 * s2 + 1][3]); pb[s2] = __builtin_bit_cast(bf16x8, pk); } \
                    _Pragma("unroll") for (int vt = 0; vt < 2; ++vt) { \
                        f32x4 ot = (f32x4){0.f, 0.f, 0.f, 0.f}; \
                        _Pragma("unroll") for (int s2 = 0; s2 < 2; ++s2) { if (2 * s2 <= (it)) { \
                            const u32x2 lo = *(const u32x2*)(sVT + (16 * vt + fr) * 72 + 32 * s2 + 4 * g), hi = *(const u32x2*)(sVT + (16 * vt + fr) * 72 + 32 * s2 + 16 + 4 * g); \
                            u32x4 av; av[0] = lo[0]; av[1] = lo[1]; av[2] = hi[0]; av[3] = hi[1]; \
                            ot = __builtin_amdgcn_mfma_f32_16x16x32_bf16(__builtin_bit_cast(bf16x8, av), pb[s2], ot, 0, 0, 0); } } \
                        _Pragma("unroll") for (int ds = 0; ds < 4; ++ds) { const bf16x8 sf = *(const bf16x8*)(sST + (16 * vt + fr) * 136 + 32 * ds + 8 * g); \
                            ot = __builtin_amdgcn_mfma_f32_16x16x32_bf16(sf, qf[ds], ot, 0, 0, 0); } \
                        const int irow = 16 * (it) + fr; const int t_ = dir ? 4095 - (64 * c + irow) : 64 * c + irow; \
                        f16x4 o_; o_[0] = (f16)ot[0]; o_[1] = (f16)ot[1]; o_[2] = (f16)ot[2]; o_[3] = (f16)ot[3]; \
                        *(f16x4*)(OS + ((size_t)dir * 16384 + (size_t)b * 4096 + t_) * 1024 + 256 * h + 32 * vs + 16 * vt + 4 * g) = o_; } } while (0)
                if (gw == 0) { GL_IT(0); GL_IT(3); } else { GL_IT(1); GL_IT(2); }
#undef GL_IT
                SC_BAR();
                CONV_STEP();
#pragma unroll
                for (int dl = 0; dl < 4; ++dl) { const int dt = 4 * gw + dl;
#pragma unroll
                    for (int vt = 0; vt < 2; ++vt) { f32x4 kv = Sacc[dl][vt];
#pragma unroll
                        for (int s2 = 0; s2 < 2; ++s2) { const bf16x8 af = *(const bf16x8*)(sKT + (16 * dt + fr) * 72 + 32 * s2 + 8 * g), bfv = *(const bf16x8*)(sVT + (16 * vt + fr) * 72 + 32 * s2 + 8 * g);
                            kv = __builtin_amdgcn_mfma_f32_16x16x32_bf16(af, bfv, kv, 0, 0, 0); }
                        const f32x4 dc = *(const f32x4*)(sDEC + 16 * dt + 4 * g);
#pragma unroll
                        for (int r = 0; r < 4; ++r) kv[r] *= dc[r];
                        Sacc[dl][vt] = kv;
                        u32x2 w_; w_[0] = cvt_pk_bf16(kv[0], kv[1]); w_[1] = cvt_pk_bf16(kv[2], kv[3]);
                        *(u32x2*)(sST + (16 * vt + fr) * 136 + 16 * dt + 4 * g) = w_; } }
                SC_BAR();
                CONV_STEP();
                SC_BAR();
            }
            while (cpid <= cend) CONV_STEP();
#undef CONV_STEP
#undef GL_LOADG
        }
        __syncthreads();
    }
}

__device__ __forceinline__ void phase_finalize(const Params& p) {
    const f16* Z = (const f16*)(p.ws + OFF_Z); const f16* WAG = (const f16*)(p.ws + OFF_WAG); const f16* YS = (const f16*)(p.ws + OFF_YS); const f16* OS = (const f16*)(p.ws + OFF_OS);
    u16* YC = (u16*)(p.ws + OFF_H);
    const int gtid = blockIdx.x * 512 + ltid(), nth = gridDim.x * 512;
    const f16x8 zero8 = {(f16)0.f, (f16)0.f, (f16)0.f, (f16)0.f, (f16)0.f, (f16)0.f, (f16)0.f, (f16)0.f};
    const int c0 = 64 * ((gtid >> 3) & 15) + 8 * (gtid & 7);
    float pmu_r[8], pmu_k[8], pmu_v[8], pka[8], prk[8], pgg[8], pgb[8];
#pragma unroll
    for (int j = 0; j < 8; ++j) { pmu_r[j] = p.rwkv_mu[c0 + j]; pmu_k[j] = p.rwkv_mu[1024 + c0 + j]; pmu_v[j] = p.rwkv_mu[2048 + c0 + j]; pka[j] = p.rwkv_k_a[c0 + j]; prk[j] = p.rwkv_r_k[c0 + j];
        pgg[j] = p.rwkv_gn_g[c0 + j]; pgb[j] = p.rwkv_gn_b[c0 + j]; }
    for (int idx = gtid; idx < 16384 * 16 * 8; idx += nth) {
        const int it = idx >> 3, m = it >> 4, t = m & 4095;
        const f16* zp = Z + (size_t)m * ZLD + c0;
        const f16x8 zr1 = *(const f16x8*)zp, zk1 = *(const f16x8*)(zp + 1024), zv1 = *(const f16x8*)(zp + 2048);
        f16x8 zr0 = zero8, zk0 = zero8, zv0 = zero8, zr2 = zero8, zk2 = zero8, zv2 = zero8;
        if (t > 0) { zr0 = *(const f16x8*)(zp - ZLD); zk0 = *(const f16x8*)(zp - ZLD + 1024); zv0 = *(const f16x8*)(zp - ZLD + 2048); }
        if (t < 4095) { zr2 = *(const f16x8*)(zp + ZLD); zk2 = *(const f16x8*)(zp + ZLD + 1024); zv2 = *(const f16x8*)(zp + ZLD + 2048); }
        const f16x8 za = *(const f16x8*)(WAG + (size_t)m * 4096 + 2048 + c0), zg = *(const f16x8*)(WAG + (size_t)m * 4096 + 3072 + c0);
        const f16x8 y0 = __builtin_nontemporal_load((const f16x8*)(YS + (size_t)m * 1024 + c0)), y1 = __builtin_nontemporal_load((const f16x8*)(YS + ((size_t)16384 + m) * 1024 + c0));
        float yv[8], vv[8]; float sum = 0.f, bon = 0.f;
#pragma unroll
        for (int j = 0; j < 8; ++j) {
            const float r1 = (float)zr1[j], k1 = (float)zk1[j], v1 = (float)zv1[j];
            const float rr = r1 + (0.5f * ((float)zr0[j] + (float)zr2[j]) - r1) * pmu_r[j];
            const float kx = k1 + (0.5f * ((float)zk0[j] + (float)zk2[j]) - k1) * pmu_k[j];
            vv[j] = v1 + (0.5f * ((float)zv0[j] + (float)zv2[j]) - v1) * pmu_v[j];
            const float kp = kx * (1.0f + ((float)za[j] - 1.0f) * pka[j]);
            bon += rr * kp * prk[j];
            yv[j] = (float)y0[j] + (float)y1[j]; sum += yv[j];
        }
        sum += __shfl_xor(sum, 1); sum += __shfl_xor(sum, 2); sum += __shfl_xor(sum, 4);
        bon += __shfl_xor(bon, 1); bon += __shfl_xor(bon, 2); bon += __shfl_xor(bon, 4);
        const float mean = sum * (1.0f / 64.0f); float sq = 0.f;
#pragma unroll
        for (int j = 0; j < 8; ++j) { const float d = yv[j] - mean; sq += d * d; }
        sq += __shfl_xor(sq, 1); sq += __shfl_xor(sq, 2); sq += __shfl_xor(sq, 4);
        const float rs = rsqrtf(sq * (1.0f / 64.0f) + 64e-5f);
        float ov[8];
#pragma unroll
        for (int j = 0; j < 8; ++j) { const float yn = (yv[j] - mean) * rs * pgg[j] + pgb[j]; ov[j] = (yn + bon * vv[j]) * (float)zg[j]; }
        u32x4 o; o[0] = cvt_pk_bf16(ov[0], ov[1]); o[1] = cvt_pk_bf16(ov[2], ov[3]); o[2] = cvt_pk_bf16(ov[4], ov[5]); o[3] = cvt_pk_bf16(ov[6], ov[7]);
        *(u32x4*)(YC + (size_t)m * 2048 + c0) = o;
    }
    float png[8];
#pragma unroll
    for (int j = 0; j < 8; ++j) png[j] = p.gla_norm_g[8 * (gtid & 31) + j];
    for (int idx = gtid; idx < 16384 * 4 * 32; idx += nth) {
        const int cg = idx & 31, it = idx >> 5, h = it & 3, m = it >> 2, c0 = 256 * h + 8 * cg;
        const f16x8 o0 = __builtin_nontemporal_load((const f16x8*)(OS + (size_t)m * 1024 + c0)), o1 = __builtin_nontemporal_load((const f16x8*)(OS + ((size_t)16384 + m) * 1024 + c0));
        const f16x8 og = *(const f16x8*)(Z + (size_t)m * ZLD + 5584 + c0);
        float ov[8]; float sq = 0.f;
#pragma unroll
        for (int j = 0; j < 8; ++j) { ov[j] = (float)o0[j] + (float)o1[j]; sq += ov[j] * ov[j]; }
        sq += __shfl_xor(sq, 1); sq += __shfl_xor(sq, 2); sq += __shfl_xor(sq, 4); sq += __shfl_xor(sq, 8); sq += __shfl_xor(sq, 16);
        const float rs = rsqrtf(sq * (1.0f / 256.0f) + 1e-5f);
        float r[8];
#pragma unroll
        for (int j = 0; j < 8; ++j) { const float gg = (float)og[j]; r[j] = ov[j] * rs * png[j] * (gg * sigmoidf_(gg)); }
        u32x4 o; o[0] = cvt_pk_bf16(r[0], r[1]); o[1] = cvt_pk_bf16(r[2], r[3]); o[2] = cvt_pk_bf16(r[4], r[5]); o[3] = cvt_pk_bf16(r[6], r[7]);
        *(u32x4*)(YC + (size_t)m * 2048 + 1024 + c0) = o;
    }
}

__device__ __forceinline__ void phase_ln(const Params& p, int s) {
    const float* xin = s == 0 ? p.x : p.out; const f16* Y = (const f16*)(p.ws + OFF_WAG);
    const float* mods = (const float*)(p.ws + OFF_MODS); u16* H = (u16*)(p.ws + OFF_H);
    const float* lg = p.ln_g + s * 2048; const float* lb = p.ln_b + s * 2048;
    const int wid = ltid() >> 6, lane = ltid() & 63;
    for (int row = blockIdx.x * 8 + wid; row < 16384; row += gridDim.x * 8) {
        const int b = row >> 12; const float* gate = mods + (size_t)s * 24576 + b * 6144 + 4096;
        f32x4 v[8]; float sum = 0.f;
#pragma unroll
        for (int i = 0; i < 8; ++i) { const int c = i * 256 + lane * 4;
            const f32x4 xv = __builtin_nontemporal_load((const f32x4*)(xin + (size_t)row * 2048 + c)), gt = *(const f32x4*)(gate + c); const f16x4 yv = __builtin_nontemporal_load((const f16x4*)(Y + (size_t)row * 2048 + c));
#pragma unroll
            for (int j = 0; j < 4; ++j) { v[i][j] = ALPHA_C * xv[j] + (1.0f + gt[j]) * (float)yv[j]; sum += v[i][j]; } }
        sum = wave_sum(sum); const float mean = sum * (1.0f / 2048.0f); float sq = 0.f;
#pragma unroll
        for (int i = 0; i < 8; ++i)
#pragma unroll
            for (int j = 0; j < 4; ++j) { const float d = v[i][j] - mean; sq += d * d; }
        sq = wave_sum(sq); const float rs = rsqrtf(sq * (1.0f / 2048.0f) + 1e-5f);
#pragma unroll
        for (int i = 0; i < 8; ++i) { const int c = i * 256 + lane * 4; const f32x4 g4 = *(const f32x4*)(lg + c), b4 = *(const f32x4*)(lb + c); f32x4 xn;
#pragma unroll
            for (int j = 0; j < 4; ++j) xn[j] = (v[i][j] - mean) * rs * g4[j] + b4[j];
            __builtin_nontemporal_store(xn, (f32x4*)(p.out + (size_t)row * 2048 + c));
            if (s < 3) { const float* mn = mods + (size_t)(s + 1) * 24576 + b * 6144; const f32x4 sh = *(const f32x4*)(mn + c), scl = *(const f32x4*)(mn + 2048 + c);
                u32x2 o; o[0] = cvt_pk_bf16(xn[0] * (1.f + scl[0]) + sh[0], xn[1] * (1.f + scl[1]) + sh[1]); o[1] = cvt_pk_bf16(xn[2] * (1.f + scl[2]) + sh[2], xn[3] * (1.f + scl[3]) + sh[3]);
                *(u32x2*)(H + (size_t)row * 2048 + c) = o; } }
    }
}

__device__ __forceinline__ void phase_attn(const Params& p, unsigned char* lds) {
    const u16* QK = (const u16*)(p.ws + OFF_Z); const u16* VT = (const u16*)(p.ws + OFF_VT); u16* O = (u16*)(p.ws + OFF_YS);
    const int tid = ltid(), wid = tid >> 6, lane = tid & 63, cmap = wid >> 2, qsub = wid & 3, ql = lane & 31, g = lane >> 5;
    float lam;
    { const float a = p.diff_lambda[lane] * p.diff_lambda[64 + lane], bq = p.diff_lambda[128 + lane] * p.diff_lambda[192 + lane];
      lam = __expf(wave_sum(a)) - __expf(wave_sum(bq)) + LINIT; }
    u16* sKt = (u16*)lds;
    u16* sVt = (u16*)(lds + 34816);
    float* ex = (float*)lds;
    const int pql = (ql & ~12) | ((ql & 4) << 1) | ((ql & 8) >> 1);
    for (int unit = blockIdx.x; unit < 2048; unit += gridDim.x) {
        int qb = unit & 31, bh = unit >> 5;
        if (gridDim.x == 256) { bh = (unit >> 8) * 8 + (blockIdx.x & 7); qb = blockIdx.x >> 3; }
        const int h = bh & 15, b = bh >> 4;
        const size_t qrow = (size_t)b * 4096 + 128 * qb + 32 * qsub + ql;
        bf16x8 Qr[4];
#pragma unroll
        for (int ks = 0; ks < 4; ++ks) Qr[ks] = *(const bf16x8*)(QK + qrow * 4096 + 128 * h + 64 * cmap + 16 * ks + 8 * g);
        f32x16 ot[4];
#pragma unroll
        for (int vb = 0; vb < 4; ++vb)
#pragma unroll
            for (int i = 0; i < 16; ++i) ot[vb][i] = 0.f;
        float mrun = -1e30f, lsum = 0.f;
        const u16* kbase = QK + (size_t)b * 4096 * 4096 + 2048 + 128 * h;
        const u16* vbase = VT + (size_t)(b * 16 + h) * 128 * 4096;
        u32x4 kr[2], vr[2];
#define AT_LOADK(kt) do { _Pragma("unroll") for (int i_ = 0; i_ < 2; ++i_) { const int id_ = tid + 512 * i_; \
            kr[i_] = *(const u32x4*)(kbase + (size_t)((kt) * 64 + (id_ >> 4)) * 4096 + (id_ & 15) * 8); } } while (0)
#define AT_LOADV(kt) do { _Pragma("unroll") for (int i_ = 0; i_ < 2; ++i_) { const int id_ = tid + 512 * i_; \
            vr[i_] = *(const u32x4*)(vbase + (size_t)(id_ >> 3) * 4096 + (kt) * 64 + (id_ & 7) * 8); } } while (0)
#define AT_STOREK(buf) do { _Pragma("unroll") for (int i_ = 0; i_ < 2; ++i_) { const int id_ = tid + 512 * i_; \
            *(u32x4*)(sKt + (buf) * 8704 + (id_ >> 4) * 136 + (id_ & 15) * 8) = kr[i_]; } } while (0)
#define AT_STOREV(buf) do { _Pragma("unroll") for (int i_ = 0; i_ < 2; ++i_) { const int id_ = tid + 512 * i_; \
            *(u32x4*)(sVt + (buf) * 9216 + (id_ >> 3) * 72 + (id_ & 7) * 8) = vr[i_]; } } while (0)
#define AT_QK(dst, buf) do { bf16x8 kf_[2][4]; \
            _Pragma("unroll") for (int ks = 0; ks < 4; ++ks) kf_[0][ks] = *(const bf16x8*)(sKt + (buf) * 8704 + pql * 136 + 64 * cmap + 16 * ks + 8 * g); \
            _Pragma("unroll") for (int kb = 0; kb < 2; ++kb) { \
                if (kb == 0) { _Pragma("unroll") for (int ks = 0; ks < 4; ++ks) kf_[1][ks] = *(const bf16x8*)(sKt + (buf) * 8704 + (32 + pql) * 136 + 64 * cmap + 16 * ks + 8 * g); } \
                __builtin_amdgcn_sched_barrier(0); \
                _Pragma("unroll") for (int i = 0; i < 16; ++i) dst[kb][i] = 0.f; \
                __builtin_amdgcn_s_setprio(2); \
                _Pragma("unroll") for (int ks = 0; ks < 4; ++ks) dst[kb] = __builtin_amdgcn_mfma_f32_32x32x16_bf16(kf_[kb][ks], Qr[ks], dst[kb], 0, 0, 0); \
                __builtin_amdgcn_s_setprio(0); \
                __builtin_amdgcn_sched_barrier(0); } } while (0)
        const int toff = 2 * qb;
        AT_LOADK(toff & 63); AT_LOADV(toff & 63); AT_STOREK(0); AT_STOREV(0);
        __syncthreads();
        f32x16 st[2];
        for (int kt = 0; kt < 64; ++kt) {
            const int buf = kt & 1;
            if (kt + 1 < 64) { AT_LOADK((kt + 1 + toff) & 63); AT_LOADV((kt + 1 + toff) & 63); }
            AT_QK(st, buf);
            float mloc = st[0][0];
#pragma unroll
            for (int i = 0; i < 16; ++i) { mloc = fmaxf(mloc, st[0][i]); mloc = fmaxf(mloc, st[1][i]); }
            mloc = fmaxf(mloc, __shfl_xor(mloc, 32));
            const float mnew = fmaxf(mrun, mloc);
            if (__builtin_amdgcn_ballot_w64(mnew > mrun) != 0ull) {
                const float alpha = __builtin_amdgcn_exp2f(mrun - mnew);
                lsum *= alpha;
#pragma unroll
                for (int vb = 0; vb < 4; ++vb)
#pragma unroll
                    for (int i = 0; i < 16; ++i) ot[vb][i] *= alpha;
            }
            mrun = mnew;
            bf16x8 P[2][2];
#pragma unroll
            for (int kb = 0; kb < 2; ++kb)
#pragma unroll
                for (int s2 = 0; s2 < 2; ++s2) { u32x4 pk;
#pragma unroll
                    for (int jj = 0; jj < 4; ++jj) { const float p0 = __builtin_amdgcn_exp2f(st[kb][8 * s2 + 2 * jj] - mnew), p1 = __builtin_amdgcn_exp2f(st[kb][8 * s2 + 2 * jj + 1] - mnew); lsum += p0 + p1; pk[jj] = cvt_pk_bf16(p0, p1); }
                    P[kb][s2] = __builtin_bit_cast(bf16x8, pk); }
            {
                bf16x8 vf[2][4];
#define AT_LDV(set, vb) do { _Pragma("unroll") for (int kb = 0; kb < 2; ++kb) _Pragma("unroll") for (int s2 = 0; s2 < 2; ++s2) \
                    vf[set][kb * 2 + s2] = *(const bf16x8*)(sVt + buf * 9216 + (32 * (vb) + ql) * 72 + 32 * kb + 16 * s2 + 8 * g); } while (0)
                AT_LDV(0, 0);
#pragma unroll
                for (int vb = 0; vb < 4; ++vb) {
                    if (vb < 3) AT_LDV((vb + 1) & 1, vb + 1);
                    __builtin_amdgcn_sched_barrier(0);
                    __builtin_amdgcn_s_setprio(2);
#pragma unroll
                    for (int kb = 0; kb < 2; ++kb)
#pragma unroll
                        for (int s2 = 0; s2 < 2; ++s2) ot[vb] = __builtin_amdgcn_mfma_f32_32x32x16_bf16(vf[vb & 1][kb * 2 + s2], P[kb][s2], ot[vb], 0, 0, 0);
                    __builtin_amdgcn_s_setprio(0);
                    __builtin_amdgcn_sched_barrier(0);
                }
#undef AT_LDV
            }
            if (kt + 1 < 64) { AT_STOREK(buf ^ 1); AT_STOREV(buf ^ 1); }
            __syncthreads();
        }
#undef AT_LOADK
#undef AT_LOADV
#undef AT_STOREK
#undef AT_STOREV
#undef AT_QK
        lsum += __shfl_xor(lsum, 32);
        const float inv = 1.0f / lsum;
        if (cmap == 1) {
#pragma unroll
            for (int vb = 0; vb < 4; ++vb)
#pragma unroll
                for (int i = 0; i < 16; ++i) ex[(vb * 16 + i) * 256 + qsub * 64 + lane] = ot[vb][i] * inv;
        }
        __syncthreads();
        if (cmap == 0) {
            float sq = 0.f;
#pragma unroll
            for (int vb = 0; vb < 4; ++vb)
#pragma unroll
                for (int i = 0; i < 16; ++i) { const float o = ot[vb][i] * inv - lam * ex[(vb * 16 + i) * 256 + qsub * 64 + lane]; ot[vb][i] = o; sq += o * o; }
            sq += __shfl_xor(sq, 32);
            const float rs = rsqrtf(sq * (1.0f / 128.0f) + 1e-5f) * (1.0f - LINIT);
            u16* orow = O + qrow * 2048 + 128 * h;
#pragma unroll
            for (int vb = 0; vb < 4; ++vb)
#pragma unroll
                for (int i4 = 0; i4 < 4; ++i4) { const int v0 = 32 * vb + 8 * i4 + 4 * g; const f32x4 sg = *(const f32x4*)(p.diff_subln_g + v0);
                    u32x2 o; o[0] = cvt_pk_bf16(ot[vb][4 * i4] * rs * sg[0], ot[vb][4 * i4 + 1] * rs * sg[1]); o[1] = cvt_pk_bf16(ot[vb][4 * i4 + 2] * rs * sg[2], ot[vb][4 * i4 + 3] * rs * sg[3]);
                    *(u32x2*)(orow + v0) = o; }
        }
        __syncthreads();
    }
}

#define XB_TMO      128
#define XB_XCNT(j)  (256  + 64 * (j))
#define XB_XSUB(j)  (1280 + 64 * (j))
#define XB_XGEN(j)  (2304 + 64 * (j))
#define XB_TOP      3328
#define XB_TOPGEN   3392
#define XCD_BAR_WORDS 3456
#define XB_SPIN_CAP (1u << 18)
__device__ __forceinline__ unsigned xb_ld(unsigned* p)              { return __hip_atomic_load(p, __ATOMIC_RELAXED, __HIP_MEMORY_SCOPE_AGENT); }
__device__ __forceinline__ unsigned xb_add(unsigned* p, unsigned v) { return __hip_atomic_fetch_add(p, v, __ATOMIC_RELAXED, __HIP_MEMORY_SCOPE_AGENT); }
__device__ __forceinline__ unsigned xb_xcc_id() { return (unsigned)__builtin_amdgcn_s_getreg((3 << 11) | 20) & 0xFu; }
#define XB_SPIN(cond, bar) do { unsigned _sp = 0; while (cond) { __builtin_amdgcn_s_sleep(1); \
    if ((++_sp & 255u) == 0u) { if (xb_ld(&(bar)[XB_TMO])) break; if (_sp > XB_SPIN_CAP) { atomicAdd(&(bar)[XB_TMO], 1u); break; } } } } while (0)
__device__ __forceinline__ void xcd_barrier_complete(unsigned* bar, unsigned x, unsigned& nloc, unsigned& nx) {
    const unsigned G = gridDim.x;
    unsigned sum, cnt, mine, sp = 0u;
    for (;;) {
        sum = 0u; cnt = 0u; mine = 0u;
#pragma unroll
        for (unsigned j = 0; j < 16; ++j) { const unsigned c = xb_ld(&bar[XB_XCNT(j)]); sum += c; cnt += (c > 0u) ? 1u : 0u; mine = (j == x) ? c : mine; }
        if (sum == G) break;
        __builtin_amdgcn_s_sleep(1);
        if ((++sp & 255u) == 0u) { if (xb_ld(&bar[XB_TMO])) break; if (sp > XB_SPIN_CAP) { atomicAdd(&bar[XB_TMO], 1u); break; } }
    }
    nloc = mine > 0u ? mine : 1u; nx = cnt > 0u ? cnt : 1u;
}
__device__ __forceinline__ void xcd_barrier(unsigned* bar, volatile unsigned* st) {
    asm volatile("s_waitcnt vmcnt(0)" ::: "memory");
    __syncthreads();
    if (threadIdx.x == 0) {
        const unsigned x = xb_xcc_id();
        __builtin_amdgcn_s_waitcnt(0);
        unsigned nloc = st[0], nx = st[1];
        if (nloc == 0u) { xcd_barrier_complete(bar, x, nloc, nx); st[0] = nloc; st[1] = nx; }
        const unsigned old = xb_add(&bar[XB_XSUB(x)], 1u);
        const unsigned gen = old / nloc;
        if (old + 1u == (gen + 1u) * nloc) {
            __builtin_amdgcn_fence(__ATOMIC_RELEASE, "agent");
            asm volatile("s_waitcnt vmcnt(0)" ::: "memory");
            const unsigned og = xb_add(&bar[XB_TOP], 1u);
            const unsigned tg = og / nx;
            if (og + 1u == (tg + 1u) * nx) xb_add(&bar[XB_TOPGEN], 1u);
            else XB_SPIN(xb_ld(&bar[XB_TOPGEN]) == tg, bar);
            __builtin_amdgcn_fence(__ATOMIC_ACQUIRE, "agent");
            xb_add(&bar[XB_XGEN(x)], 1u);
            asm volatile("s_waitcnt vmcnt(0)" ::: "memory");
        } else {
            XB_SPIN(xb_ld(&bar[XB_XGEN(x)]) == gen, bar);
            __builtin_amdgcn_fence(__ATOMIC_ACQUIRE, "agent");
            asm volatile("s_waitcnt vmcnt(0)" ::: "memory");
        }
    }
    __syncthreads();
}

__device__ __forceinline__ void run_phase(const Params& p, int ph, unsigned char* lds) {
    unsigned char* ws = p.ws;
    switch (ph) {
    case 0: phase0(p, lds); break;
    case 1: phase_mods(p); break;
    case 2: phase_modulate(p); break;
    case 3: { EpiF16 E; E.O = (f16*)(ws + OFF_Z); E.ldc = ZLD; run_gemm(lds, (const u16*)(ws + OFF_H), (const u16*)(ws + OFF_WB_ABIN), 6656, 2048, E); } break;
    case 4: phase_prep(p, lds); break;
    case 5: { EpiWAG E; E.O = (f16*)(ws + OFF_WAG); E.w0 = p.rwkv_w0; E.a0 = p.rwkv_a0; run_gemm(lds, (const u16*)(ws + OFF_L), (const u16*)(ws + OFF_WB_LORA), 4096, 512, E); } break;
    case 6: phase_scans(p, lds); break;
    case 7: phase_finalize(p); break;
    case 8: case 11: case 15: case 18: {
        const u16* A; const u16* Bt; int K;
        if (ph == 8) { A = (const u16*)(ws + OFF_H); Bt = (const u16*)(ws + OFF_WB_ABOUT); K = 2048; }
        else if (ph == 11) { A = (const u16*)(ws + OFF_Z); Bt = (const u16*)(ws + OFF_WB_FFNOUT0); K = 5632; }
        else if (ph == 15) { A = (const u16*)(ws + OFF_YS); Bt = (const u16*)(ws + OFF_WB_DOUT); K = 2048; }
        else { A = (const u16*)(ws + OFF_Z); Bt = (const u16*)(ws + OFF_WB_FFNOUT1); K = 5632; }
        EpiF16 E; E.O = (f16*)(ws + OFF_WAG); E.ldc = 2048; run_gemm(lds, A, Bt, 2048, K, E); } break;
    case 9: case 12: case 16: case 19: phase_ln(p, ph == 9 ? 0 : (ph == 12 ? 1 : (ph == 16 ? 2 : 3))); break;
    case 10: case 17: { EpiSwiGLU E; E.O = (u16*)(ws + OFF_Z); run_gemm(lds, (const u16*)(ws + OFF_H), (const u16*)(ws + (ph == 10 ? OFF_WB_FFNIN0 : OFF_WB_FFNIN1)), 11264, 2048, E); } break;
    case 13: { EpiQKV E; E.QK = (u16*)(ws + OFF_Z); E.VT = (u16*)(ws + OFF_VT); E.cs = (const float*)(ws + OFF_ROPE); E.sn = E.cs + 4096 * 32;
               run_gemm(lds, (const u16*)(ws + OFF_H), (const u16*)(ws + OFF_WB_DIN), 6144, 2048, E); } break;
    case 14: phase_attn(p, lds); break;
    default: break;
    }
}

#if !MK_SINGLE
__global__ void __launch_bounds__(512, 2) k_phase(Params p, int ph) {
    extern __shared__ __attribute__((aligned(16))) unsigned char shm[];
    run_phase(p, ph, shm);
}
#else
__global__ void __launch_bounds__(512) __attribute__((amdgpu_waves_per_eu(2, 2))) k_mega(Params p) {
    extern __shared__ __attribute__((aligned(16))) unsigned char shm[];
    cg::grid_group grid = cg::this_grid();
    volatile unsigned* xst = (volatile unsigned*)(shm + 131072);
    if (threadIdx.x == 0) { xst[0] = 0u; xst[1] = 0u; (void)xb_add(&((unsigned*)(p.ws + OFF_BAR))[XB_XCNT(xb_xcc_id())], 1u); }
    __syncthreads();
#define PH(n) run_phase(p, n, shm); xcd_barrier((unsigned*)(p.ws + OFF_BAR), (volatile unsigned*)(shm + 131072));
    run_phase(p, 0, shm); grid.sync();
    PH(1) PH(2) PH(3) PH(4) PH(5) PH(6) PH(7) PH(8) PH(9) PH(10) PH(11) PH(12) PH(13) PH(14) PH(15) PH(16) PH(17) PH(18)
#undef PH
    run_phase(p, 19, shm);
}
#endif

extern "C" void kernel_launch(void* const* d_in, const int* in_sizes, int n_in, void* d_out, int out_size, void* d_ws, size_t ws_size, hipStream_t stream) {
    if (ws_size < WS_TOTAL) { fprintf(stderr, "workspace too small: %zu < %zu\n", ws_size, (size_t)WS_TOTAL); return; }
    Params p{};
    const float** pp = (const float**)&p;
    for (int i = 0; i < 28; ++i) pp[i] = (const float*)d_in[i];
    p.out = (float*)d_out; p.ws = (unsigned char*)d_ws;
    constexpr size_t kDynLds = 131072 + 256;
#if MK_SINGLE
    static int grid_blocks = 0;
    if (!grid_blocks) {
        hipFuncSetAttribute((const void*)k_mega, hipFuncAttributeMaxDynamicSharedMemorySize, (int)kDynLds);
        int dev = 0, cus = 0, per_cu = 0;
        hipGetDevice(&dev);
        hipDeviceGetAttribute(&cus, hipDeviceAttributeMultiprocessorCount, dev);
        hipOccupancyMaxActiveBlocksPerMultiprocessor(&per_cu, k_mega, 512, kDynLds);
        grid_blocks = cus * per_cu; if (grid_blocks > 256) grid_blocks = 256;
    }
    (void)hipMemsetAsync((unsigned char*)d_ws + OFF_BAR, 0, 16384, stream);
    void* args[] = {&p};
    hipError_t e = hipLaunchCooperativeKernel((void*)k_mega, dim3(grid_blocks), dim3(512), args, kDynLds, stream);
    if (e != hipSuccess) fprintf(stderr, "cooperative launch failed: %s (grid %d)\n", hipGetErrorString(e), grid_blocks);
#else
    static int inited = 0;
    if (!inited) { hipFuncSetAttribute((const void*)k_phase, hipFuncAttributeMaxDynamicSharedMemorySize, (int)kDynLds); inited = 1; }
    for (int ph = 0; ph < NPHASE; ++ph) k_phase<<<256, 512, kDynLds, stream>>>(p, ph);
#endif
}
```
